# Optimizing an MI355X kernel written in HIP

```python
import jax, jax.numpy as jnp
from jax import lax
import numpy as np

D_MODEL = 1024
BATCH = 16
SEQ = 2048
DEPTH = 2

GRID_W = 64
CTX_LEN = 256
Q_BLOCK = 128
ROPE_THETA = 10000.0
EPS = 1e-6
N_EVEN = (DEPTH + 1) // 2
N_ODD = DEPTH // 2
MIX_HALF = D_MODEL // 2

A_HEAD_DIM = 64
A_Q_HEADS = MIX_HALF // A_HEAD_DIM
A_KV_HEADS = 2
A_GROUP = A_Q_HEADS // A_KV_HEADS
B_GROUPS = 8
B_WIDTH = MIX_HALF
B_GROUP_DIM = B_WIDTH // B_GROUPS
B_CHUNK = 128
C_HEADS = 8
C_NOPE = 64
C_ROPE = 32
C_V = MIX_HALF // C_HEADS
C_Q_RANK = D_MODEL // 4
C_KV_RANK = D_MODEL // 8
D_WIDTH = MIX_HALF
D_CONV = 31
FF_DIM = 4 * D_MODEL
N_MOD = 6

EV_Q = A_Q_HEADS * A_HEAD_DIM
EV_KV = A_KV_HEADS * A_HEAD_DIM
EV_IN = EV_Q + 2 * EV_KV + 2 * B_WIDTH
OD_IN = C_Q_RANK + C_KV_RANK + C_ROPE + 2 * D_WIDTH

kernel_name = "hybrid_gqa_gmlp_mla_conformer_prefix_dit"


def rms_norm(x, g):
    xf = x.astype(jnp.float32)
    y = xf * lax.rsqrt(jnp.mean(xf * xf, axis=-1, keepdims=True) + EPS)
    return (y * g.astype(jnp.float32)).astype(x.dtype)


def layer_norm(x, g, b):
    xf = x.astype(jnp.float32)
    mu = jnp.mean(xf, axis=-1, keepdims=True)
    var = jnp.mean(jnp.square(xf - mu), axis=-1, keepdims=True)
    y = (xf - mu) * lax.rsqrt(var + EPS)
    return (y * g.astype(jnp.float32) + b.astype(jnp.float32)).astype(x.dtype)


def modulate(x, g, shift, scale):
    return rms_norm(x, g) * (1 + scale) + shift


def axial_angles(length, d_rot):
    rows = length // GRID_W
    row = jnp.broadcast_to(jnp.arange(rows)[:, None], (rows, GRID_W)).reshape(-1).astype(jnp.float32)
    col = jnp.broadcast_to(jnp.arange(GRID_W)[None, :], (rows, GRID_W)).reshape(-1).astype(jnp.float32)
    d_axis = d_rot // 2
    inv = ROPE_THETA ** (-jnp.arange(0, d_axis, 2, dtype=jnp.float32) / d_axis)
    return jnp.concatenate([row[:, None] * inv, col[:, None] * inv], axis=-1)


def apply_rope(x, ang):
    d = x.shape[-1]
    xf = x.astype(jnp.float32).reshape(x.shape[:-1] + (d // 2, 2))
    cos, sin = jnp.cos(ang), jnp.sin(ang)
    x0, x1 = xf[..., 0], xf[..., 1]
    out = jnp.stack([x0 * cos - x1 * sin, x0 * sin + x1 * cos], axis=-1)
    return out.reshape(x.shape).astype(x.dtype)


def to_heads(t, n_heads, head_dim):
    b, l, _ = t.shape
    return t.reshape(b, l, n_heads, head_dim).transpose(0, 2, 1, 3)


def from_heads(o):
    b, n, l, hd = o.shape
    return o.transpose(0, 2, 1, 3).reshape(b, l, n * hd)


def block_attention(q, k, v):
    b, hk, g, lq, dk = q.shape
    scale = dk ** -0.5
    qb = jnp.moveaxis(q.reshape(b, hk, g, lq // Q_BLOCK, Q_BLOCK, dk), 3, 0)

    def one_block(qi):
        s = jnp.einsum("bhgqd,bhkd->bhgqk", qi, k, preferred_element_type=jnp.float32) * scale
        p = jax.nn.softmax(s, axis=-1)
        return jnp.einsum("bhgqk,bhkd->bhgqd", p.astype(v.dtype), v)

    o = lax.map(one_block, qb)
    return jnp.moveaxis(o, 0, 3).reshape(b, hk, g, lq, v.shape[-1])


def spatial_gating(z, norm_g, w_s, b_s):
    b, l, _ = z.shape
    u, v = jnp.split(jax.nn.gelu(z), 2, axis=-1)
    v = rms_norm(v.reshape(b, l, B_GROUPS, B_GROUP_DIM), norm_g)
    v = v.reshape(b, l // B_CHUNK, B_CHUNK, B_GROUPS, B_GROUP_DIM)
    sv = jnp.einsum("gpq,bnqgc->bnpgc", w_s, v) + b_s.T[None, None, :, :, None]
    return u * sv.reshape(b, l, B_WIDTH)


def even_mixer(h_lat, h_ctx, need_ctx, w_in, q_norm_g, k_norm_g, sgu_norm_g, sgu_w, sgu_b):
    cuts = [EV_Q, EV_Q + EV_KV, EV_Q + 2 * EV_KV]
    w_q, w_k, w_v, w_z = jnp.split(w_in, cuts, axis=1)

    def gqa_q(qp, ang):
        b, l, _ = qp.shape
        q = rms_norm(to_heads(qp, A_Q_HEADS, A_HEAD_DIM), q_norm_g)
        if ang is not None:
            q = apply_rope(q, ang)
        return q.reshape(b, A_KV_HEADS, A_GROUP, l, A_HEAD_DIM)

    def gqa_kv(kp, vp, ang):
        k = rms_norm(to_heads(kp, A_KV_HEADS, A_HEAD_DIM), k_norm_g)
        if ang is not None:
            k = apply_rope(k, ang)
        return k, to_heads(vp, A_KV_HEADS, A_HEAD_DIM)

    def merge(o):
        b, hk, g, l, d = o.shape
        return from_heads(o.reshape(b, hk * g, l, d))

    b, l, _ = h_lat.shape
    ang = axial_angles(l, A_HEAD_DIM)
    qp, kp, vp, zp = jnp.split(h_lat @ w_in, cuts, axis=-1)
    kc, vc = gqa_kv(h_ctx @ w_k, h_ctx @ w_v, None)
    kl, vl = gqa_kv(kp, vp, ang)
    o_att = block_attention(gqa_q(qp, ang), jnp.concatenate([kc, kl], axis=2),
                            jnp.concatenate([vc, vl], axis=2))
    out_lat = jnp.concatenate([merge(o_att), spatial_gating(zp, sgu_norm_g, sgu_w, sgu_b)], axis=-1)
    out_ctx = None
    if need_ctx:
        oc = block_attention(gqa_q(h_ctx @ w_q, None), kc, vc)
        out_ctx = jnp.concatenate([merge(oc), spatial_gating(h_ctx @ w_z, sgu_norm_g, sgu_w, sgu_b)],
                                  axis=-1)
    return out_lat, out_ctx


def odd_mixer(h_lat, h_ctx, need_ctx, w_in, q_norm_g, kv_norm_g, w_uq, w_ukv, conv_w, conv_b,
              ln_g, ln_b):
    cuts = [C_Q_RANK, C_Q_RANK + C_KV_RANK, C_Q_RANK + C_KV_RANK + C_ROPE]
    w_cq, w_ckv, w_kr, w_cv = jnp.split(w_in, cuts, axis=1)

    def mla_q(cq, ang):
        b, l, _ = cq.shape
        q = to_heads(rms_norm(cq, q_norm_g) @ w_uq, C_HEADS, C_NOPE + C_ROPE)
        qn, qr = jnp.split(q, [C_NOPE], axis=-1)
        if ang is not None:
            qr = apply_rope(qr, ang)
        return jnp.concatenate([qn, qr], axis=-1)[:, :, None]

    def mla_kv(ckv, kr, ang):
        b, l, _ = ckv.shape
        kv = to_heads(rms_norm(ckv, kv_norm_g) @ w_ukv, C_HEADS, C_NOPE + C_V)
        kn, v = jnp.split(kv, [C_NOPE], axis=-1)
        kr = kr[:, None]
        if ang is not None:
            kr = apply_rope(kr, ang)
        k = jnp.concatenate([kn, jnp.broadcast_to(kr, (b, C_HEADS, l, C_ROPE))], axis=-1)
        return k, v

    def conformer(z):
        a, gt = jnp.split(z, 2, axis=-1)
        y = a * jax.nn.sigmoid(gt)
        y = lax.conv_general_dilated(y, conv_w[:, None, :], window_strides=(1,),
                                     padding=[(D_CONV // 2, D_CONV // 2)],
                                     dimension_numbers=("NWC", "WIO", "NWC"),
                                     feature_group_count=D_WIDTH) + conv_b
        return jax.nn.silu(layer_norm(y, ln_g, ln_b))

    b, l, _ = h_lat.shape
    ang = axial_angles(l, C_ROPE)
    cq, ckv, kr, zc = jnp.split(h_lat @ w_in, cuts, axis=-1)
    kc, vc = mla_kv(h_ctx @ w_ckv, h_ctx @ w_kr, None)
    kl, vl = mla_kv(ckv, kr, ang)
    o_att = block_attention(mla_q(cq, ang), jnp.concatenate([kc, kl], axis=2),
                            jnp.concatenate([vc, vl], axis=2))[:, :, 0]
    out_lat = jnp.concatenate([from_heads(o_att), conformer(zc)], axis=-1)
    out_ctx = None
    if need_ctx:
        oc = block_attention(mla_q(h_ctx @ w_cq, None), kc, vc)[:, :, 0]
        out_ctx = jnp.concatenate([from_heads(oc), conformer(h_ctx @ w_cv)], axis=-1)
    return out_lat, out_ctx


def sq_relu_mlp(h, w1, w2):
    return jnp.square(jax.nn.relu(h @ w1)) @ w2


def setup_inputs(seed: int = 0) -> dict:
    key = jax.random.key(seed)
    ks = jax.random.split(key, 32)

    def nrm(k, shape, scale=1.0):
        return jax.random.normal(k, shape, jnp.float32) * scale

    def gain(k, shape):
        return 1.0 + 0.05 * jax.random.normal(k, shape, jnp.float32)

    D = D_MODEL
    return {
        "x": nrm(ks[0], (BATCH, SEQ, D)),
        "c": nrm(ks[1], (BATCH, D)),
        "ctx": nrm(ks[2], (BATCH, CTX_LEN, D)),
        "c_ctx": nrm(ks[3], (D,)),
        "ada_w": nrm(ks[4], (DEPTH, D, N_MOD * D), 0.5 * D ** -0.5),
        "ada_b": nrm(ks[5], (DEPTH, N_MOD * D), 0.02),
        "norm1_g": gain(ks[6], (DEPTH, D)),
        "norm2_g": gain(ks[7], (DEPTH, D)),
        "w_out": nrm(ks[8], (DEPTH, D, D), D ** -0.5),
        "mlp_w1": nrm(ks[9], (DEPTH, D, FF_DIM), D ** -0.5),
        "mlp_w2": nrm(ks[10], (DEPTH, FF_DIM, D), FF_DIM ** -0.5),
        "ev_w_in": nrm(ks[11], (N_EVEN, D, EV_IN), D ** -0.5),
        "ev_q_norm_g": gain(ks[12], (N_EVEN, A_HEAD_DIM)),
        "ev_k_norm_g": gain(ks[13], (N_EVEN, A_HEAD_DIM)),
        "ev_sgu_norm_g": gain(ks[14], (N_EVEN, B_GROUPS, B_GROUP_DIM)),
        "ev_sgu_w": nrm(ks[15], (N_EVEN, B_GROUPS, B_CHUNK, B_CHUNK), B_CHUNK ** -0.5),
        "ev_sgu_b": gain(ks[16], (N_EVEN, B_GROUPS, B_CHUNK)),
        "od_w_in": nrm(ks[17], (N_ODD, D, OD_IN), D ** -0.5),
        "od_q_norm_g": gain(ks[18], (N_ODD, C_Q_RANK)),
        "od_kv_norm_g": gain(ks[19], (N_ODD, C_KV_RANK)),
        "od_w_uq": nrm(ks[20], (N_ODD, C_Q_RANK, C_HEADS * (C_NOPE + C_ROPE)), C_Q_RANK ** -0.5),
        "od_w_ukv": nrm(ks[21], (N_ODD, C_KV_RANK, C_HEADS * (C_NOPE + C_V)), C_KV_RANK ** -0.5),
        "od_conv_w": nrm(ks[22], (N_ODD, D_CONV, D_WIDTH), D_CONV ** -0.5),
        "od_conv_b": nrm(ks[23], (N_ODD, D_WIDTH), 0.02),
        "od_ln_g": gain(ks[24], (N_ODD, D_WIDTH)),
        "od_ln_b": nrm(ks[25], (N_ODD, D_WIDTH), 0.02),
        "final_g": gain(ks[26], (D,)),
    }


def reference(x, c, ctx, c_ctx, ada_w, ada_b, norm1_g, norm2_g, w_out, mlp_w1, mlp_w2,
              ev_w_in, ev_q_norm_g, ev_k_norm_g, ev_sgu_norm_g, ev_sgu_w, ev_sgu_b,
              od_w_in, od_q_norm_g, od_kv_norm_g, od_w_uq, od_w_ukv, od_conv_w, od_conv_b,
              od_ln_g, od_ln_b, final_g):
    x_lat, x_ctx = x, ctx
    silu_c = jax.nn.silu(c)
    silu_cc = jax.nn.silu(c_ctx)
    for i in range(DEPTH):
        last = i == DEPTH - 1
        j = i // 2
        m = jnp.split(silu_c @ ada_w[i] + ada_b[i], N_MOD, axis=-1)
        sh1, sc1, g1, sh2, sc2, g2 = [t[:, None, :] for t in m]
        sh1c, sc1c, g1c, sh2c, sc2c, g2c = jnp.split(silu_cc @ ada_w[i] + ada_b[i], N_MOD, axis=-1)

        h_lat = modulate(x_lat, norm1_g[i], sh1, sc1)
        h_ctx = modulate(x_ctx, norm1_g[i], sh1c, sc1c)
        if i % 2 == 0:
            o_lat, o_ctx = even_mixer(h_lat, h_ctx, not last, ev_w_in[j], ev_q_norm_g[j],
                                      ev_k_norm_g[j], ev_sgu_norm_g[j], ev_sgu_w[j], ev_sgu_b[j])
        else:
            o_lat, o_ctx = odd_mixer(h_lat, h_ctx, not last, od_w_in[j], od_q_norm_g[j],
                                     od_kv_norm_g[j], od_w_uq[j], od_w_ukv[j], od_conv_w[j],
                                     od_conv_b[j], od_ln_g[j], od_ln_b[j])

        x_lat = x_lat + g1 * (o_lat @ w_out[i])
        x_lat = x_lat + g2 * sq_relu_mlp(modulate(x_lat, norm2_g[i], sh2, sc2), mlp_w1[i], mlp_w2[i])
        if not last:
            x_ctx = x_ctx + g1c * (o_ctx @ w_out[i])
            x_ctx = x_ctx + g2c * sq_relu_mlp(modulate(x_ctx, norm2_g[i], sh2c, sc2c),
                                              mlp_w1[i], mlp_w2[i])
    return rms_norm(x_lat, final_g)
```

```cpp
#include <hip/hip_runtime.h>
#include <hip/hip_cooperative_groups.h>
#include <cstdio>
namespace cg = cooperative_groups;

#ifndef MK_COOP
#define MK_COOP 0
#endif

typedef unsigned short bf16_t;
typedef short bf16x8 __attribute__((ext_vector_type(8)));
typedef short bf16x4 __attribute__((ext_vector_type(4)));
typedef float f32x4 __attribute__((ext_vector_type(4)));
typedef unsigned u32x4 __attribute__((ext_vector_type(4)));
typedef unsigned u32x2 __attribute__((ext_vector_type(2)));

#define NLAT 32768
#define NCTX 4096
#define NTOK 36864
#define LK 2304
#define EPSF 1e-6f
#define LOG2_THETA 13.287712379549449f

constexpr size_t al256(size_t x) { return (x + 255) & ~(size_t)255; }
constexpr size_t OFF_EVWIN = 0;
constexpr size_t OFF_ODWIN = OFF_EVWIN + al256((size_t)1792 * 1024 * 2);
constexpr size_t OFF_WOUT = OFF_ODWIN + al256((size_t)1536 * 1024 * 2);
constexpr size_t OFF_W1 = OFF_WOUT + al256((size_t)2 * 1024 * 1024 * 2);
constexpr size_t OFF_W2 = OFF_W1 + al256((size_t)2 * 4096 * 1024 * 2);
constexpr size_t OFF_WUQ = OFF_W2 + al256((size_t)2 * 4096 * 1024 * 2);
constexpr size_t OFF_WUKV = OFF_WUQ + al256((size_t)768 * 256 * 2);
constexpr size_t OFF_SGUW = OFF_WUKV + al256((size_t)1024 * 128 * 2);
constexpr size_t OFF_MOD = OFF_SGUW + al256((size_t)8 * 128 * 128 * 2);
constexpr size_t OFF_SSQ = OFF_MOD + al256((size_t)2 * 17 * 6144 * 4);
constexpr size_t OFF_XCTX = OFF_SSQ + al256((size_t)2 * NTOK * 4);
constexpr size_t OFF_H = OFF_XCTX + al256((size_t)NCTX * 1024 * 4);
constexpr size_t OFF_BIG = OFF_H + al256((size_t)NTOK * 1024 * 2);
constexpr size_t OFF_HID = OFF_BIG;
constexpr size_t OFF_OMIX = OFF_BIG;
constexpr size_t OFF_R = OFF_OMIX + al256((size_t)NTOK * 1024 * 2);
constexpr size_t OFF_Q = OFF_R;
constexpr size_t OFF_QC = OFF_Q + al256((size_t)16 * 8 * 2048 * 64 * 2);
constexpr size_t OFF_K = OFF_QC + al256((size_t)16 * 8 * 256 * 64 * 2);
constexpr size_t OFF_VT = OFF_K + al256((size_t)16 * 2 * LK * 64 * 2);
constexpr size_t OFF_U = OFF_VT + al256((size_t)16 * 2 * LK * 64 * 2);
constexpr size_t OFF_VGT = OFF_U + al256((size_t)NTOK * 512 * 2);
constexpr size_t OFF_CQ = OFF_R;
constexpr size_t OFF_CKV = OFF_CQ + al256((size_t)NTOK * 256 * 2);
constexpr size_t OFF_GLU = OFF_CKV + al256((size_t)NTOK * 128 * 2);
constexpr size_t OFF_Q2 = OFF_GLU + al256((size_t)NTOK * 512 * 2);
constexpr size_t OFF_K2 = OFF_Q2 + al256((size_t)16 * 8 * 2048 * 96 * 2);
constexpr size_t OFF_V2T = OFF_K2 + al256((size_t)16 * 8 * LK * 96 * 2);
constexpr size_t OFF_END1 = OFF_V2T + al256((size_t)16 * 8 * 64 * LK * 2);
constexpr size_t OFF_END = OFF_BIG + al256((size_t)NTOK * 4096 * 2);
static_assert(OFF_END1 <= OFF_END, "layer-1 scratch must fit under hid");

struct Params {
    const float *x, *c, *ctx, *c_ctx, *ada_w, *ada_b, *norm1_g, *norm2_g, *w_out, *mlp_w1, *mlp_w2;
    const float *ev_w_in, *ev_q_norm_g, *ev_k_norm_g, *ev_sgu_norm_g, *ev_sgu_w, *ev_sgu_b;
    const float *od_w_in, *od_q_norm_g, *od_kv_norm_g, *od_w_uq, *od_w_ukv, *od_conv_w, *od_conv_b, *od_ln_g, *od_ln_b, *final_g;
    float* out;
    char* ws;
};

__device__ __forceinline__ unsigned pack_bf16(float lo, float hi) {
    unsigned r;
    asm("v_cvt_pk_bf16_f32 %0, %1, %2" : "=v"(r) : "v"(lo), "v"(hi));
    return r;
}
__device__ __forceinline__ bf16_t f2bf(float f) { return (bf16_t)(pack_bf16(f, 0.f) & 0xffffu); }
__device__ __forceinline__ float bf_lo(unsigned u) { return __uint_as_float(u << 16); }
__device__ __forceinline__ float bf_hi(unsigned u) { return __uint_as_float(u & 0xffff0000u); }
__device__ __forceinline__ void store_bf16x4(bf16_t* p, float a, float b, float c, float d) {
    u32x2 v; v.x = pack_bf16(a, b); v.y = pack_bf16(c, d);
    *(u32x2*)p = v;
}
__device__ __forceinline__ void tokinfo(int row, int& b, int& l, bool& isctx) {
    if (row < NLAT) { b = row >> 11; l = row & 2047; isctx = false; }
    else { int r = row - NLAT; b = r >> 8; l = r & 255; isctx = true; }
}
__device__ __forceinline__ float gelu_tanh(float x) {
    float u = 0.7978845608028654f * (x + 0.044715f * x * x * x);
    return x / (1.f + __expf(-2.f * u));
}
__device__ __forceinline__ float sigmoidf_(float x) { return 1.f / (1.f + __expf(-x)); }
__device__ __forceinline__ void rot(float& x0, float& x1, float ang) {
    float rev = ang * 0.15915494309189535f;
    float s = __builtin_amdgcn_sinf(rev), c = __builtin_amdgcn_cosf(rev);
    float a = x0 * c - x1 * s, b = x0 * s + x1 * c;
    x0 = a; x1 = b;
}

template <class Epi>
__device__ __forceinline__ void gemm_tile(const bf16_t* __restrict__ A, int lda, const bf16_t* __restrict__ Bt, int ldb, int K,
                                          int pm, int pn, const Epi& epi, char* smem) {
    bf16_t* sA = (bf16_t*)smem;
    bf16_t* sB = sA + 128 * 64;
    const int tid = threadIdx.x, lane = tid & 63, w = tid >> 6, wm = w >> 1, wn = w & 1, fr = lane & 15, fq = lane >> 4;
    const int srow = tid >> 3, skc = tid & 7;
    const bf16_t* Ag = A + (size_t)(pm * 128 + srow) * lda + skc * 8;
    const bf16_t* Bg = Bt + (size_t)(pn * 128 + srow) * ldb + skc * 8;
    const int swo = srow * 64 + ((skc ^ ((srow >> 1) & 7)) * 8);
    u32x4 ra[4], rb[4];
    f32x4 acc[4][4];
#pragma unroll
    for (int i = 0; i < 4; ++i)
#pragma unroll
        for (int j = 0; j < 4; ++j) acc[i][j] = (f32x4){0.f, 0.f, 0.f, 0.f};
#pragma unroll
    for (int i = 0; i < 4; ++i) {
        ra[i] = *(const u32x4*)(Ag + (size_t)(32 * i) * lda);
        rb[i] = *(const u32x4*)(Bg + (size_t)(32 * i) * ldb);
    }
    const int nk = K >> 6;
    const int sw = (fr >> 1) & 7;
    for (int kt = 0; kt < nk; ++kt) {
        __syncthreads();
#pragma unroll
        for (int i = 0; i < 4; ++i) {
            *(u32x4*)(sA + swo + i * 32 * 64) = ra[i];
            *(u32x4*)(sB + swo + i * 32 * 64) = rb[i];
        }
        __syncthreads();
        if (kt + 1 < nk) {
#pragma unroll
            for (int i = 0; i < 4; ++i) {
                ra[i] = *(const u32x4*)(Ag + (size_t)(32 * i) * lda + (kt + 1) * 64);
                rb[i] = *(const u32x4*)(Bg + (size_t)(32 * i) * ldb + (kt + 1) * 64);
            }
        }
#pragma unroll
        for (int kk = 0; kk < 2; ++kk) {
            bf16x8 af[4], bfr[4];
            const int co = ((kk * 4 + fq) ^ sw) * 8;
#pragma unroll
            for (int mi = 0; mi < 4; ++mi) af[mi] = *(const bf16x8*)(sA + (wm * 64 + mi * 16 + fr) * 64 + co);
#pragma unroll
            for (int ni = 0; ni < 4; ++ni) bfr[ni] = *(const bf16x8*)(sB + (wn * 64 + ni * 16 + fr) * 64 + co);
#pragma unroll
            for (int mi = 0; mi < 4; ++mi)
#pragma unroll
                for (int ni = 0; ni < 4; ++ni)
                    acc[mi][ni] = __builtin_amdgcn_mfma_f32_16x16x32_bf16(bfr[ni], af[mi], acc[mi][ni], 0, 0, 0);
        }
    }
    epi(acc, pm * 128 + wm * 64, pn * 128 + wn * 64, fr, fq);
}

struct EpiEvenIn {
    bf16_t *Q, *Qc, *K, *Vt, *U, *VgT;
    const float *qg, *kg, *sg;
    __device__ __forceinline__ void operator()(f32x4 (&acc)[4][4], int m0, int n0, int fr, int fq) const {
        if (n0 < 640) {
            const bool isq = n0 < 512;
            const int head = isq ? (n0 >> 6) : ((n0 - 512) >> 6);
            const float* g = isq ? qg : kg;
            f32x4 gv[4];
#pragma unroll
            for (int ni = 0; ni < 4; ++ni) gv[ni] = *(const f32x4*)(g + ni * 16 + 4 * fq);
#pragma unroll
            for (int mi = 0; mi < 4; ++mi) {
                const int row = m0 + mi * 16 + fr;
                int b, l; bool isctx; tokinfo(row, b, l, isctx);
                float ss = 0.f;
#pragma unroll
                for (int ni = 0; ni < 4; ++ni)
#pragma unroll
                    for (int j = 0; j < 4; ++j) ss += acc[mi][ni][j] * acc[mi][ni][j];
                ss += __shfl_xor(ss, 16); ss += __shfl_xor(ss, 32);
                const float r = rsqrtf(ss * (1.f / 64.f) + EPSF);
                bf16_t* dst;
                if (isq) dst = isctx ? Qc + ((size_t)((b * 8 + head) * 256 + l)) * 64 : Q + ((size_t)((b * 8 + head) * 2048 + l)) * 64;
                else dst = K + ((size_t)((b * 2 + head) * LK + (isctx ? l : 256 + l))) * 64;
                const float frow = (float)(l >> 6), fcol = (float)(l & 63);
#pragma unroll
                for (int ni = 0; ni < 4; ++ni) {
                    float v[4];
#pragma unroll
                    for (int j = 0; j < 4; ++j) v[j] = acc[mi][ni][j] * r * gv[ni][j];
                    if (!isctx) {
#pragma unroll
                        for (int p = 0; p < 2; ++p) {
                            const int i = ni * 8 + 2 * fq + p;
                            const float inv = __builtin_amdgcn_exp2f(-(float)(i & 15) * (LOG2_THETA / 16.f));
                            const float ang = (i < 16 ? frow : fcol) * inv;
                            rot(v[2 * p], v[2 * p + 1], ang);
                        }
                    }
                    store_bf16x4(dst + ni * 16 + 4 * fq, v[0], v[1], v[2], v[3]);
                }
            }
        } else if (n0 < 768) {
            const int hk = (n0 - 640) >> 6;
#pragma unroll
            for (int mi = 0; mi < 4; ++mi) {
                const int row = m0 + mi * 16 + fr;
                int b, l; bool isctx; tokinfo(row, b, l, isctx);
                const int pos = isctx ? l : 256 + l;
                bf16_t* dst = Vt + ((size_t)(b * 2 + hk) * 64) * LK + pos;
#pragma unroll
                for (int ni = 0; ni < 4; ++ni)
#pragma unroll
                    for (int j = 0; j < 4; ++j) dst[(size_t)(ni * 16 + 4 * fq + j) * LK] = f2bf(acc[mi][ni][j]);
            }
        } else {
            const int zc = n0 - 768;
            if (zc < 512) {
#pragma unroll
                for (int mi = 0; mi < 4; ++mi) {
                    const int row = m0 + mi * 16 + fr;
#pragma unroll
                    for (int ni = 0; ni < 4; ++ni)
                        store_bf16x4(U + (size_t)row * 512 + zc + ni * 16 + 4 * fq, gelu_tanh(acc[mi][ni][0]), gelu_tanh(acc[mi][ni][1]),
                                     gelu_tanh(acc[mi][ni][2]), gelu_tanh(acc[mi][ni][3]));
                }
            } else {
                const int g = (zc - 512) >> 6;
                f32x4 gv[4];
#pragma unroll
                for (int ni = 0; ni < 4; ++ni) gv[ni] = *(const f32x4*)(sg + g * 64 + ni * 16 + 4 * fq);
#pragma unroll
                for (int mi = 0; mi < 4; ++mi) {
                    const int row = m0 + mi * 16 + fr;
                    float v[4][4];
                    float ss = 0.f;
#pragma unroll
                    for (int ni = 0; ni < 4; ++ni)
#pragma unroll
                        for (int j = 0; j < 4; ++j) { v[ni][j] = gelu_tanh(acc[mi][ni][j]); ss += v[ni][j] * v[ni][j]; }
                    ss += __shfl_xor(ss, 16); ss += __shfl_xor(ss, 32);
                    const float r = rsqrtf(ss * (1.f / 64.f) + EPSF);
                    bf16_t* dst = VgT + ((size_t)(g * 288 + (row >> 7)) * 64) * 128 + (row & 127);
#pragma unroll
                    for (int ni = 0; ni < 4; ++ni)
#pragma unroll
                        for (int j = 0; j < 4; ++j) dst[(size_t)(ni * 16 + 4 * fq + j) * 128] = f2bf(v[ni][j] * r * gv[ni][j]);
                }
            }
        }
    }
};

struct EpiResid {
    const float *xin_lat, *xin_ctx; float *xout_lat, *xout_ctx; const float* gate;
    __device__ __forceinline__ void operator()(f32x4 (&acc)[4][4], int m0, int n0, int fr, int fq) const {
#pragma unroll
        for (int mi = 0; mi < 4; ++mi) {
            const int row = m0 + mi * 16 + fr;
            int b, l; bool isctx; tokinfo(row, b, l, isctx);
            const float* gp = gate + (size_t)(isctx ? 16 : b) * 6144 + n0 + 4 * fq;
            const float* xi = (isctx ? xin_ctx + (size_t)(row - NLAT) * 1024 : xin_lat + (size_t)row * 1024) + n0 + 4 * fq;
            float* xo = (isctx ? xout_ctx + (size_t)(row - NLAT) * 1024 : xout_lat + (size_t)row * 1024) + n0 + 4 * fq;
#pragma unroll
            for (int ni = 0; ni < 4; ++ni) {
                const f32x4 g4 = *(const f32x4*)(gp + ni * 16);
                const f32x4 x4 = *(const f32x4*)(xi + ni * 16);
                *(f32x4*)(xo + ni * 16) = x4 + g4 * acc[mi][ni];
            }
        }
    }
};

struct EpiSqRelu {
    bf16_t* hid;
    __device__ __forceinline__ void operator()(f32x4 (&acc)[4][4], int m0, int n0, int fr, int fq) const {
#pragma unroll
        for (int mi = 0; mi < 4; ++mi) {
            const int row = m0 + mi * 16 + fr;
#pragma unroll
            for (int ni = 0; ni < 4; ++ni) {
                float v[4];
#pragma unroll
                for (int j = 0; j < 4; ++j) { float t = fmaxf(acc[mi][ni][j], 0.f); v[j] = t * t; }
                store_bf16x4(hid + (size_t)row * 4096 + n0 + ni * 16 + 4 * fq, v[0], v[1], v[2], v[3]);
            }
        }
    }
};

struct EpiOddIn {
    bf16_t *CQ, *CKV, *K2, *GLU; float *ssq_q, *ssq_kv;
    __device__ __forceinline__ void operator()(f32x4 (&acc)[4][4], int m0, int n0, int fr, int fq) const {
        if (n0 < 384) {
            const bool isq = n0 < 256;
#pragma unroll
            for (int mi = 0; mi < 4; ++mi) {
                const int row = m0 + mi * 16 + fr;
                float ss = 0.f;
                bf16_t* dst = isq ? CQ + (size_t)row * 256 + n0 : CKV + (size_t)row * 128 + (n0 - 256);
#pragma unroll
                for (int ni = 0; ni < 4; ++ni) {
#pragma unroll
                    for (int j = 0; j < 4; ++j) ss += acc[mi][ni][j] * acc[mi][ni][j];
                    store_bf16x4(dst + ni * 16 + 4 * fq, acc[mi][ni][0], acc[mi][ni][1], acc[mi][ni][2], acc[mi][ni][3]);
                }
                ss += __shfl_xor(ss, 16); ss += __shfl_xor(ss, 32);
                if (fq == 0) atomicAdd((isq ? ssq_q : ssq_kv) + row, ss);
            }
        } else if (n0 < 448) {
#pragma unroll
            for (int mi = 0; mi < 4; ++mi) {
                const int row = m0 + mi * 16 + fr;
                int b, l; bool isctx; tokinfo(row, b, l, isctx);
                const int pos = isctx ? l : 256 + l;
                const float frow = (float)(l >> 6), fcol = (float)(l & 63);
#pragma unroll
                for (int ni = 0; ni < 2; ++ni) {
                    float v[4];
#pragma unroll
                    for (int j = 0; j < 4; ++j) v[j] = acc[mi][ni][j];
                    if (!isctx) {
#pragma unroll
                        for (int p = 0; p < 2; ++p) {
                            const int i = ni * 8 + 2 * fq + p;
                            const float inv = __builtin_amdgcn_exp2f(-(float)(i & 7) * (LOG2_THETA / 8.f));
                            rot(v[2 * p], v[2 * p + 1], (i < 8 ? frow : fcol) * inv);
                        }
                    }
#pragma unroll
                    for (int h = 0; h < 8; ++h)
                        store_bf16x4(K2 + ((size_t)((b * 8 + h) * LK + pos)) * 96 + 64 + ni * 16 + 4 * fq, v[0], v[1], v[2], v[3]);
                }
            }
        } else if (n0 >= 512) {
            const int wt = (n0 - 512) >> 6;
#pragma unroll
            for (int mi = 0; mi < 4; ++mi) {
                const int row = m0 + mi * 16 + fr;
#pragma unroll
                for (int ni = 0; ni < 2; ++ni) {
                    float v[4];
#pragma unroll
                    for (int j = 0; j < 4; ++j) v[j] = acc[mi][ni][j] * sigmoidf_(acc[mi][ni + 2][j]);
                    store_bf16x4(GLU + (size_t)row * 512 + wt * 32 + ni * 16 + 4 * fq, v[0], v[1], v[2], v[3]);
                }
            }
        }
    }
};

struct EpiQUp {
    bf16_t* Q2; const float* ssq_q;
    __device__ __forceinline__ void operator()(f32x4 (&acc)[4][4], int m0, int n0, int fr, int fq) const {
#pragma unroll
        for (int mi = 0; mi < 4; ++mi) {
            const int row = m0 + mi * 16 + fr;
            const int b = row >> 11, l = row & 2047;
            const float r = rsqrtf(ssq_q[row] * (1.f / 256.f) + EPSF);
            const float frow = (float)(l >> 6), fcol = (float)(l & 63);
#pragma unroll
            for (int ni = 0; ni < 4; ++ni) {
                const int col = n0 + ni * 16 + 4 * fq;
                const int h = col / 96, d = col - h * 96;
                float v[4];
#pragma unroll
                for (int j = 0; j < 4; ++j) v[j] = acc[mi][ni][j] * r;
                if (d >= 64) {
#pragma unroll
                    for (int p = 0; p < 2; ++p) {
                        const int i = ((d - 64) >> 1) + p;
                        const float inv = __builtin_amdgcn_exp2f(-(float)(i & 7) * (LOG2_THETA / 8.f));
                        rot(v[2 * p], v[2 * p + 1], (i < 8 ? frow : fcol) * inv);
                    }
                }
                store_bf16x4(Q2 + ((size_t)((b * 8 + h) * 2048 + l)) * 96 + d, v[0], v[1], v[2], v[3]);
            }
        }
    }
};

struct EpiKVUp {
    bf16_t *K2, *V2t; const float* ssq_kv;
    __device__ __forceinline__ void operator()(f32x4 (&acc)[4][4], int m0, int n0, int fr, int fq) const {
        const int h = n0 >> 7;
        const bool isv = (n0 & 64) != 0;
#pragma unroll
        for (int mi = 0; mi < 4; ++mi) {
            const int row = m0 + mi * 16 + fr;
            int b, l; bool isctx; tokinfo(row, b, l, isctx);
            const int pos = isctx ? l : 256 + l;
            const float r = rsqrtf(ssq_kv[row] * (1.f / 128.f) + EPSF);
            if (!isv) {
                bf16_t* dst = K2 + ((size_t)((b * 8 + h) * LK + pos)) * 96;
#pragma unroll
                for (int ni = 0; ni < 4; ++ni)
                    store_bf16x4(dst + ni * 16 + 4 * fq, acc[mi][ni][0] * r, acc[mi][ni][1] * r, acc[mi][ni][2] * r, acc[mi][ni][3] * r);
            } else {
                bf16_t* dst = V2t + ((size_t)(b * 8 + h) * 64) * LK + pos;
#pragma unroll
                for (int ni = 0; ni < 4; ++ni)
#pragma unroll
                    for (int j = 0; j < 4; ++j) dst[(size_t)(ni * 16 + 4 * fq + j) * LK] = f2bf(acc[mi][ni][j] * r);
            }
        }
    }
};

struct EpiGate {
    const bf16_t* U; bf16_t* Omix; const float* bias; int g;
    __device__ __forceinline__ void operator()(f32x4 (&acc)[4][4], int m0, int n0, int fr, int fq) const {
#pragma unroll
        for (int mi = 0; mi < 4; ++mi) {
            const int pp = m0 + mi * 16 + fr;
            const float bs = bias[pp];
#pragma unroll
            for (int ni = 0; ni < 4; ++ni) {
                const int col = n0 + ni * 16 + 4 * fq;
                const int chunk = col >> 6, c = col & 63;
                const size_t tok = (size_t)chunk * 128 + pp;
                const u32x2 u = *(const u32x2*)(U + tok * 512 + g * 64 + c);
                store_bf16x4(Omix + tok * 1024 + 512 + g * 64 + c, (acc[mi][ni][0] + bs) * bf_lo(u.x), (acc[mi][ni][1] + bs) * bf_hi(u.x),
                             (acc[mi][ni][2] + bs) * bf_lo(u.y), (acc[mi][ni][3] + bs) * bf_hi(u.y));
            }
        }
    }
};

template <int DQK>
__device__ __forceinline__ void attn_item(const bf16_t* __restrict__ Qb, const bf16_t* __restrict__ Kb, const bf16_t* __restrict__ Vtb,
                                          bf16_t* __restrict__ Omix, int item, int Lq, int nkeys, int hk_div, int rowbase, float cexp, char* smem) {
    constexpr int KSTR = (DQK == 64) ? 64 : 128;
    constexpr int NDC = DQK / 32;
    constexpr int KCH = DQK / 8;
    constexpr int NKL = KCH / 4;
    bf16_t* sK = (bf16_t*)smem;
    bf16_t* sV = sK + 64 * KSTR;
    const int tid = threadIdx.x, lane = tid & 63, w = tid >> 6, fr = lane & 15, fq = lane >> 4;
    const int nqt = Lq >> 7;
    const int qt = item % nqt, h = (item / nqt) & 7, b = item / (nqt * 8);
    const int nkvh = 8 / hk_div, hk = h / hk_div;
    const bf16_t* Qp = Qb + ((size_t)((b * 8 + h) * Lq + qt * 128 + w * 32)) * DQK;
    const bf16_t* Kp = Kb + (size_t)(b * nkvh + hk) * LK * DQK;
    const bf16_t* Vp = Vtb + (size_t)(b * nkvh + hk) * 64 * LK;

    bf16x8 qf[2][NDC];
#pragma unroll
    for (int qb = 0; qb < 2; ++qb)
#pragma unroll
        for (int dc = 0; dc < NDC; ++dc) qf[qb][dc] = *(const bf16x8*)(Qp + (qb * 16 + fr) * DQK + dc * 32 + fq * 8);

    int koff_g[NKL], koff_s[NKL];
#pragma unroll
    for (int i = 0; i < NKL; ++i) {
        const int c = tid + 256 * i, row = c / KCH, ch = c % KCH;
        koff_g[i] = row * DQK + ch * 8;
        koff_s[i] = (DQK == 64) ? row * 64 + ((ch ^ ((row >> 1) & 7)) * 8) : row * 128 + ((ch ^ (row & 15)) * 8);
    }
    u32x4 rk[NKL], rv[2];
#pragma unroll
    for (int i = 0; i < NKL; ++i) rk[i] = *(const u32x4*)(Kp + koff_g[i]);
#pragma unroll
    for (int i = 0; i < 2; ++i) { const int c = tid + 256 * i; rv[i] = *(const u32x4*)(Vp + (size_t)(c >> 3) * LK + (c & 7) * 8); }

    f32x4 o[2][4];
    float m[2], lsum[2];
#pragma unroll
    for (int qb = 0; qb < 2; ++qb) {
        m[qb] = -1e30f; lsum[qb] = 0.f;
#pragma unroll
        for (int d = 0; d < 4; ++d) o[qb][d] = (f32x4){0.f, 0.f, 0.f, 0.f};
    }
    const int nt = nkeys >> 6;
    for (int kt = 0; kt < nt; ++kt) {
        __syncthreads();
#pragma unroll
        for (int i = 0; i < NKL; ++i) *(u32x4*)(sK + koff_s[i]) = rk[i];
#pragma unroll
        for (int i = 0; i < 2; ++i) { const int c = tid + 256 * i; *(u32x4*)(sV + (c >> 3) * 72 + (c & 7) * 8) = rv[i]; }
        __syncthreads();
        if (kt + 1 < nt) {
#pragma unroll
            for (int i = 0; i < NKL; ++i) rk[i] = *(const u32x4*)(Kp + (size_t)(kt + 1) * 64 * DQK + koff_g[i]);
#pragma unroll
            for (int i = 0; i < 2; ++i) { const int c = tid + 256 * i; rv[i] = *(const u32x4*)(Vp + (size_t)(c >> 3) * LK + (kt + 1) * 64 + (c & 7) * 8); }
        }
        f32x4 s[2][4];
#pragma unroll
        for (int kb = 0; kb < 4; ++kb) {
#pragma unroll
            for (int qb = 0; qb < 2; ++qb) s[qb][kb] = (f32x4){0.f, 0.f, 0.f, 0.f};
#pragma unroll
            for (int dc = 0; dc < NDC; ++dc) {
                const int row = kb * 16 + fr, ch = dc * 4 + fq;
                const int off = (DQK == 64) ? row * 64 + ((ch ^ ((row >> 1) & 7)) * 8) : row * 128 + ((ch ^ (row & 15)) * 8);
                const bf16x8 kf = *(const bf16x8*)(sK + off);
#pragma unroll
                for (int qb = 0; qb < 2; ++qb) s[qb][kb] = __builtin_amdgcn_mfma_f32_16x16x32_bf16(kf, qf[qb][dc], s[qb][kb], 0, 0, 0);
            }
        }
        bf16x8 pb[2][2];
#pragma unroll
        for (int qb = 0; qb < 2; ++qb) {
            float mx = s[qb][0][0];
#pragma unroll
            for (int kb = 0; kb < 4; ++kb)
#pragma unroll
                for (int j = 0; j < 4; ++j) mx = fmaxf(mx, s[qb][kb][j]);
            mx = fmaxf(mx, __shfl_xor(mx, 16)); mx = fmaxf(mx, __shfl_xor(mx, 32));
            const float mnew = fmaxf(m[qb], mx);
            const float alpha = __builtin_amdgcn_exp2f((m[qb] - mnew) * cexp);
            m[qb] = mnew;
            const float mc = mnew * cexp;
            float ps = 0.f;
            unsigned pk[8];
#pragma unroll
            for (int kb = 0; kb < 4; ++kb) {
                float p0 = __builtin_amdgcn_exp2f(s[qb][kb][0] * cexp - mc), p1 = __builtin_amdgcn_exp2f(s[qb][kb][1] * cexp - mc);
                float p2 = __builtin_amdgcn_exp2f(s[qb][kb][2] * cexp - mc), p3 = __builtin_amdgcn_exp2f(s[qb][kb][3] * cexp - mc);
                ps += (p0 + p1) + (p2 + p3);
                pk[kb * 2] = pack_bf16(p0, p1); pk[kb * 2 + 1] = pack_bf16(p2, p3);
            }
            lsum[qb] = lsum[qb] * alpha + ps;
            u32x4 t0 = {pk[0], pk[1], pk[2], pk[3]}, t1 = {pk[4], pk[5], pk[6], pk[7]};
            pb[qb][0] = __builtin_bit_cast(bf16x8, t0);
            pb[qb][1] = __builtin_bit_cast(bf16x8, t1);
#pragma unroll
            for (int d = 0; d < 4; ++d) o[qb][d] *= alpha;
        }
#pragma unroll
        for (int dvb = 0; dvb < 4; ++dvb)
#pragma unroll
            for (int ks = 0; ks < 2; ++ks) {
                const bf16_t* vp = sV + (dvb * 16 + fr) * 72 + ks * 32 + fq * 4;
                const u32x2 v0 = *(const u32x2*)vp, v1 = *(const u32x2*)(vp + 16);
                    u32x4 t = {v0.x, v0.y, v1.x, v1.y};
                const bf16x8 vf = __builtin_bit_cast(bf16x8, t);
#pragma unroll
                for (int qb = 0; qb < 2; ++qb) o[qb][dvb] = __builtin_amdgcn_mfma_f32_16x16x32_bf16(vf, pb[qb][ks], o[qb][dvb], 0, 0, 0);
            }
    }
#pragma unroll
    for (int qb = 0; qb < 2; ++qb) {
        float lt = lsum[qb];
        lt += __shfl_xor(lt, 16); lt += __shfl_xor(lt, 32);
        const float inv = 1.f / lt;
        const size_t row = (size_t)rowbase + (size_t)b * Lq + qt * 128 + w * 32 + qb * 16 + fr;
#pragma unroll
        for (int dvb = 0; dvb < 4; ++dvb)
            store_bf16x4(Omix + row * 1024 + h * 64 + dvb * 16 + fq * 4, o[qb][dvb][0] * inv, o[qb][dvb][1] * inv, o[qb][dvb][2] * inv, o[qb][dvb][3] * inv);
    }
}

__device__ __forceinline__ void conv_item(const bf16_t* __restrict__ GLU, const float* __restrict__ cw, const float* __restrict__ cb,
                                          const float* __restrict__ lg, const float* __restrict__ lb, bf16_t* __restrict__ Omix, int item, char* smem) {
    float* red = (float*)smem;
    const int tid = threadIdx.x, lane = tid & 63, w = tid >> 6;
    const int ch = 2 * tid;
    float w0[31], w1[31];
#pragma unroll
    for (int j = 0; j < 31; ++j) { const float2 t = *(const float2*)(cw + j * 512 + ch); w0[j] = t.x; w1[j] = t.y; }
    const float2 cbv = *(const float2*)(cb + ch);
    const float2 lgv = *(const float2*)(lg + ch), lbv = *(const float2*)(lb + ch);
#pragma unroll 1
    for (int half = 0; half < 2; ++half) {
        const int tok0 = item * 16 + half * 8, b = tok0 >> 11, l0 = tok0 & 2047;
        unsigned g[38];
#pragma unroll
        for (int i = 0; i < 38; ++i) {
            const int l = l0 - 15 + i;
            g[i] = (l >= 0 && l < 2048) ? *(const unsigned*)(GLU + ((size_t)(b * 2048 + l)) * 512 + ch) : 0u;
        }
        float y0[8], y1[8];
#pragma unroll
        for (int t = 0; t < 8; ++t) {
            float a0 = cbv.x, a1 = cbv.y;
#pragma unroll
            for (int j = 0; j < 31; ++j) { a0 += w0[j] * bf_lo(g[t + j]); a1 += w1[j] * bf_hi(g[t + j]); }
            y0[t] = a0; y1[t] = a1;
        }
        __syncthreads();
#pragma unroll
        for (int t = 0; t < 8; ++t) {
            float s = y0[t] + y1[t];
#pragma unroll
            for (int o = 32; o >= 1; o >>= 1) s += __shfl_xor(s, o);
            if (lane == 0) red[w * 8 + t] = s;
        }
        __syncthreads();
#pragma unroll
        for (int t = 0; t < 8; ++t) {
            const float mean = (red[t] + red[8 + t] + red[16 + t] + red[24 + t]) * (1.f / 512.f);
            y0[t] -= mean; y1[t] -= mean;
            float s = y0[t] * y0[t] + y1[t] * y1[t];
#pragma unroll
            for (int o = 32; o >= 1; o >>= 1) s += __shfl_xor(s, o);
            if (lane == 0) red[32 + w * 8 + t] = s;
        }
        __syncthreads();
#pragma unroll
        for (int t = 0; t < 8; ++t) {
            const float var = (red[32 + t] + red[40 + t] + red[48 + t] + red[56 + t]) * (1.f / 512.f);
            const float r = rsqrtf(var + EPSF);
            float a = y0[t] * r * lgv.x + lbv.x, c = y1[t] * r * lgv.y + lbv.y;
            a = a * sigmoidf_(a); c = c * sigmoidf_(c);
            *(unsigned*)(Omix + (size_t)(tok0 + t) * 1024 + 512 + ch) = pack_bf16(a, c);
        }
    }
}

__device__ __forceinline__ void modulate_item(const float* __restrict__ xlat, const float* __restrict__ xctx, const float* __restrict__ ng,
                                              const float* __restrict__ modl, int sh_off, int sc_off, bf16_t* __restrict__ h, int item) {
    const int lane = threadIdx.x & 63, w = threadIdx.x >> 6;
    const int row = item * 4 + w;
    int b, l; bool isctx; tokinfo(row, b, l, isctx);
    const float* x = isctx ? xctx + (size_t)(row - NLAT) * 1024 : xlat + (size_t)row * 1024;
    const float* mp = modl + (size_t)(isctx ? 16 : b) * 6144;
    f32x4 v[4];
    float ss = 0.f;
#pragma unroll
    for (int i = 0; i < 4; ++i) {
        v[i] = *(const f32x4*)(x + i * 256 + lane * 4);
        ss += v[i][0] * v[i][0] + v[i][1] * v[i][1] + v[i][2] * v[i][2] + v[i][3] * v[i][3];
    }
#pragma unroll
    for (int o = 32; o >= 1; o >>= 1) ss += __shfl_xor(ss, o);
    const float r = rsqrtf(ss * (1.f / 1024.f) + EPSF);
#pragma unroll
    for (int i = 0; i < 4; ++i) {
        const int col = i * 256 + lane * 4;
        const f32x4 g4 = *(const f32x4*)(ng + col), sc = *(const f32x4*)(mp + sc_off + col), sh = *(const f32x4*)(mp + sh_off + col);
        float y[4];
#pragma unroll
        for (int j = 0; j < 4; ++j) y[j] = v[i][j] * r * g4[j] * (1.f + sc[j]) + sh[j];
        store_bf16x4(h + (size_t)row * 1024 + col, y[0], y[1], y[2], y[3]);
    }
}
__device__ __forceinline__ void finalnorm_item(float* __restrict__ x, const float* __restrict__ g, int item) {
    const int lane = threadIdx.x & 63, w = threadIdx.x >> 6;
    float* xr = x + (size_t)(item * 4 + w) * 1024;
    f32x4 v[4];
    float ss = 0.f;
#pragma unroll
    for (int i = 0; i < 4; ++i) {
        v[i] = *(const f32x4*)(xr + i * 256 + lane * 4);
        ss += v[i][0] * v[i][0] + v[i][1] * v[i][1] + v[i][2] * v[i][2] + v[i][3] * v[i][3];
    }
#pragma unroll
    for (int o = 32; o >= 1; o >>= 1) ss += __shfl_xor(ss, o);
    const float r = rsqrtf(ss * (1.f / 1024.f) + EPSF);
#pragma unroll
    for (int i = 0; i < 4; ++i) {
        const f32x4 g4 = *(const f32x4*)(g + i * 256 + lane * 4);
        *(f32x4*)(xr + i * 256 + lane * 4) = v[i] * r * g4;
    }
}

__device__ __forceinline__ int odmap(int n) {
    if (n < 416) return n;
    if (n < 512) return -1;
    const int t = n - 512, wt = t >> 6, c = t & 63;
    return 416 + (c < 32 ? wt * 32 + c : 512 + wt * 32 + (c - 32));
}
template <bool ODMAP>
__device__ __forceinline__ void tconv_tile(const float* __restrict__ src, int ldsrc, bf16_t* __restrict__ dst, int K, const float* __restrict__ rs,
                                           int tile, char* smem) {
    float* t = (float*)smem;
    const int nkt = K >> 6;
    const int kt = tile % nkt, ntile = tile / nkt;
    const int k0 = kt * 64, n0 = ntile * 64;
    const int tid = threadIdx.x;
    __syncthreads();
    {
        const int n = tid & 63;
        const int sn = ODMAP ? odmap(n0 + n) : n0 + n;
#pragma unroll
        for (int i = 0; i < 16; ++i) {
            const int k = i * 4 + (tid >> 6);
            float v = sn >= 0 ? src[(size_t)(k0 + k) * ldsrc + sn] : 0.f;
            if (rs) v *= rs[k0 + k];
            t[k * 65 + n] = v;
        }
    }
    __syncthreads();
#pragma unroll
    for (int j = 0; j < 2; ++j) {
        const int n = (tid >> 3) + 32 * j, kc = (tid & 7) * 8;
        u32x4 o;
        o.x = pack_bf16(t[(kc + 0) * 65 + n], t[(kc + 1) * 65 + n]);
        o.y = pack_bf16(t[(kc + 2) * 65 + n], t[(kc + 3) * 65 + n]);
        o.z = pack_bf16(t[(kc + 4) * 65 + n], t[(kc + 5) * 65 + n]);
        o.w = pack_bf16(t[(kc + 6) * 65 + n], t[(kc + 7) * 65 + n]);
        *(u32x4*)(dst + (size_t)(n0 + n) * K + k0 + kc) = o;
    }
}
__device__ __forceinline__ void ada_item(const Params& p, float* __restrict__ mod, int item, char* smem) {
    float* s = (float*)smem;
    const int tid = threadIdx.x;
    const int layer = item / 96, n0 = (item % 96) * 64;
    const int col = tid & 63, ks = tid >> 6;
    float acc[17];
#pragma unroll
    for (int r = 0; r < 17; ++r) acc[r] = 0.f;
    for (int half = 0; half < 2; ++half) {
        __syncthreads();
        for (int idx = tid; idx < 17 * 512; idx += 256) {
            const int r = idx >> 9, k = (idx & 511) + half * 512;
            const float v = r < 16 ? p.c[r * 1024 + k] : p.c_ctx[k];
            s[idx] = v * sigmoidf_(v);
        }
        __syncthreads();
        const float* wp = p.ada_w + ((size_t)layer * 1024 + half * 512 + ks * 128) * 6144 + n0 + col;
        for (int k = 0; k < 128; ++k) {
            const float wv = wp[(size_t)k * 6144];
#pragma unroll
            for (int r = 0; r < 17; ++r) acc[r] += s[r * 512 + ks * 128 + k] * wv;
        }
    }
    __syncthreads();
#pragma unroll
    for (int r = 0; r < 17; ++r) s[(ks * 17 + r) * 64 + col] = acc[r];
    __syncthreads();
    for (int idx = tid; idx < 17 * 64; idx += 256) {
        const int r = idx >> 6, cc = idx & 63;
        const float v = s[(0 * 17 + r) * 64 + cc] + s[(1 * 17 + r) * 64 + cc] + s[(2 * 17 + r) * 64 + cc] + s[(3 * 17 + r) * 64 + cc];
        mod[((size_t)layer * 17 + r) * 6144 + n0 + cc] = v + p.ada_b[layer * 6144 + n0 + cc];
    }
}

constexpr int P0_EV = (1792 / 64) * 16;
constexpr int P0_OD = (1536 / 64) * 16;
constexpr int P0_WO = 2 * 16 * 16;
constexpr int P0_W1 = 2 * 64 * 16;
constexpr int P0_W2 = 2 * 16 * 64;
constexpr int P0_UQ = (768 / 64) * 4;
constexpr int P0_UKV = (1024 / 64) * 2;
constexpr int P0_SGU = 128;
constexpr int P0_ZERO = 72;
constexpr int P0_ADA = 192;
constexpr int P0_TOTAL = P0_ADA + P0_EV + P0_OD + P0_WO + P0_W1 + P0_W2 + P0_UQ + P0_UKV + P0_SGU + P0_ZERO;

__device__ __forceinline__ void phase0_item(const Params& p, int it, char* smem) {
    char* ws = p.ws;
    if (it < P0_ADA) { ada_item(p, (float*)(ws + OFF_MOD), it, smem); return; }
    it -= P0_ADA;
    if (it < P0_EV) { tconv_tile<false>(p.ev_w_in, 1792, (bf16_t*)(ws + OFF_EVWIN), 1024, nullptr, it, smem); return; }
    it -= P0_EV;
    if (it < P0_OD) { tconv_tile<true>(p.od_w_in, 1440, (bf16_t*)(ws + OFF_ODWIN), 1024, nullptr, it, smem); return; }
    it -= P0_OD;
    if (it < P0_WO) { const int l = it / 256; tconv_tile<false>(p.w_out + (size_t)l * 1024 * 1024, 1024, (bf16_t*)(ws + OFF_WOUT) + (size_t)l * 1024 * 1024, 1024, nullptr, it % 256, smem); return; }
    it -= P0_WO;
    if (it < P0_W1) { const int l = it / 1024; tconv_tile<false>(p.mlp_w1 + (size_t)l * 1024 * 4096, 4096, (bf16_t*)(ws + OFF_W1) + (size_t)l * 4096 * 1024, 1024, nullptr, it % 1024, smem); return; }
    it -= P0_W1;
    if (it < P0_W2) { const int l = it / 1024; tconv_tile<false>(p.mlp_w2 + (size_t)l * 4096 * 1024, 1024, (bf16_t*)(ws + OFF_W2) + (size_t)l * 1024 * 4096, 4096, nullptr, it % 1024, smem); return; }
    it -= P0_W2;
    if (it < P0_UQ) { tconv_tile<false>(p.od_w_uq, 768, (bf16_t*)(ws + OFF_WUQ), 256, p.od_q_norm_g, it, smem); return; }
    it -= P0_UQ;
    if (it < P0_UKV) { tconv_tile<false>(p.od_w_ukv, 1024, (bf16_t*)(ws + OFF_WUKV), 128, p.od_kv_norm_g, it, smem); return; }
    it -= P0_UKV;
    if (it < P0_SGU) {
        const int e = it * 1024 + threadIdx.x * 4;
        const f32x4 v = *(const f32x4*)(p.ev_sgu_w + e);
        store_bf16x4((bf16_t*)(ws + OFF_SGUW) + e, v[0], v[1], v[2], v[3]);
        return;
    }
    it -= P0_SGU;
    { *(f32x4*)((float*)(ws + OFF_SSQ) + it * 1024 + threadIdx.x * 4) = (f32x4){0.f, 0.f, 0.f, 0.f}; }
}

#define NPHASES 17
#define SMEM_BYTES 34816

__device__ __forceinline__ void run_phase(const Params& p, int ph, char* smem) {
    char* ws = p.ws;
    const int G = gridDim.x, B = blockIdx.x;
    float* mod = (float*)(ws + OFF_MOD);
    float* xctx = (float*)(ws + OFF_XCTX);
    bf16_t* h = (bf16_t*)(ws + OFF_H);
    bf16_t* hid = (bf16_t*)(ws + OFF_HID);
    bf16_t* omix = (bf16_t*)(ws + OFF_OMIX);
    float* ssq_q = (float*)(ws + OFF_SSQ);
    float* ssq_kv = ssq_q + NTOK;
    switch (ph) {
    case 0:
        for (int it = B; it < P0_TOTAL; it += G) phase0_item(p, it, smem);
        break;
    case 1:
        for (int it = B; it < NTOK / 4; it += G) modulate_item(p.x, p.ctx, p.norm1_g, mod, 0, 1024, h, it);
        break;
    case 2: {
        EpiEvenIn e{(bf16_t*)(ws + OFF_Q), (bf16_t*)(ws + OFF_QC), (bf16_t*)(ws + OFF_K), (bf16_t*)(ws + OFF_VT), (bf16_t*)(ws + OFF_U),
                    (bf16_t*)(ws + OFF_VGT), p.ev_q_norm_g, p.ev_k_norm_g, p.ev_sgu_norm_g};
        const int nN = 1792 / 128, nt = (NTOK / 128) * nN;
        for (int t = B; t < nt; t += G) gemm_tile(h, 1024, (const bf16_t*)(ws + OFF_EVWIN), 1024, 1024, t / nN, t % nN, e, smem);
    } break;
    case 3: {
        const int n1 = 16 * 8 * 16, n2 = 16 * 8 * 2, n3 = 8 * 144;
        const float cexp = 0.125f * 1.4426950408889634f;
        for (int it = B; it < n1 + n2 + n3; it += G) {
            if (it < n1) attn_item<64>((const bf16_t*)(ws + OFF_Q), (const bf16_t*)(ws + OFF_K), (const bf16_t*)(ws + OFF_VT), omix, it, 2048, LK, 4, 0, cexp, smem);
            else if (it < n1 + n2) attn_item<64>((const bf16_t*)(ws + OFF_QC), (const bf16_t*)(ws + OFF_K), (const bf16_t*)(ws + OFF_VT), omix, it - n1, 256, 256, 4, NLAT, cexp, smem);
            else {
                const int t = it - n1 - n2, g = t / 144, pn = t % 144;
                EpiGate e{(const bf16_t*)(ws + OFF_U), omix, p.ev_sgu_b + g * 128, g};
                gemm_tile((const bf16_t*)(ws + OFF_SGUW) + g * 16384, 128, (const bf16_t*)(ws + OFF_VGT) + (size_t)g * 288 * 64 * 128, 128, 128, 0, pn, e, smem);
            }
        }
    } break;
    case 4: {
        EpiResid e{p.x, p.ctx, p.out, xctx, mod + 2 * 1024};
        const int nt = (NTOK / 128) * 8;
        for (int t = B; t < nt; t += G) gemm_tile(omix, 1024, (const bf16_t*)(ws + OFF_WOUT), 1024, 1024, t >> 3, t & 7, e, smem);
    } break;
    case 5:
        for (int it = B; it < NTOK / 4; it += G) modulate_item(p.out, xctx, p.norm2_g, mod, 3 * 1024, 4 * 1024, h, it);
        break;
    case 6: {
        EpiSqRelu e{hid};
        const int nt = (NTOK / 128) * 32;
        for (int t = B; t < nt; t += G) gemm_tile(h, 1024, (const bf16_t*)(ws + OFF_W1), 1024, 1024, t >> 5, t & 31, e, smem);
    } break;
    case 7: {
        EpiResid e{p.out, xctx, p.out, xctx, mod + 5 * 1024};
        const int nt = (NTOK / 128) * 8;
        for (int t = B; t < nt; t += G) gemm_tile(hid, 4096, (const bf16_t*)(ws + OFF_W2), 4096, 4096, t >> 3, t & 7, e, smem);
    } break;
    case 8:
        for (int it = B; it < NTOK / 4; it += G) modulate_item(p.out, xctx, p.norm1_g + 1024, mod + 17 * 6144, 0, 1024, h, it);
        break;
    case 9: {
        EpiOddIn e{(bf16_t*)(ws + OFF_CQ), (bf16_t*)(ws + OFF_CKV), (bf16_t*)(ws + OFF_K2), (bf16_t*)(ws + OFF_GLU), ssq_q, ssq_kv};
        const int nN = 12, nt = (NTOK / 128) * nN;
        for (int t = B; t < nt; t += G) gemm_tile(h, 1024, (const bf16_t*)(ws + OFF_ODWIN), 1024, 1024, t / nN, t % nN, e, smem);
    } break;
    case 10: {
        const int n1 = (NLAT / 128) * 6, n2 = (NTOK / 128) * 8, n3 = NLAT / 16;
        EpiQUp eq{(bf16_t*)(ws + OFF_Q2), ssq_q};
        EpiKVUp ek{(bf16_t*)(ws + OFF_K2), (bf16_t*)(ws + OFF_V2T), ssq_kv};
        for (int it = B; it < n1 + n2 + n3; it += G) {
            if (it < n1) gemm_tile((const bf16_t*)(ws + OFF_CQ), 256, (const bf16_t*)(ws + OFF_WUQ), 256, 256, it / 6, it % 6, eq, smem);
            else if (it < n1 + n2) { const int t = it - n1; gemm_tile((const bf16_t*)(ws + OFF_CKV), 128, (const bf16_t*)(ws + OFF_WUKV), 128, 128, t >> 3, t & 7, ek, smem); }
            else conv_item((const bf16_t*)(ws + OFF_GLU), p.od_conv_w, p.od_conv_b, p.od_ln_g, p.od_ln_b, omix, it - n1 - n2, smem);
        }
    } break;
    case 11: {
        const float cexp = 0.10206207261596575f * 1.4426950408889634f;
        for (int it = B; it < 16 * 8 * 16; it += G)
            attn_item<96>((const bf16_t*)(ws + OFF_Q2), (const bf16_t*)(ws + OFF_K2), (const bf16_t*)(ws + OFF_V2T), omix, it, 2048, LK, 1, 0, cexp, smem);
    } break;
    case 12: {
        EpiResid e{p.out, xctx, p.out, xctx, mod + 17 * 6144 + 2 * 1024};
        const int nt = (NLAT / 128) * 8;
        for (int t = B; t < nt; t += G) gemm_tile(omix, 1024, (const bf16_t*)(ws + OFF_WOUT) + 1024 * 1024, 1024, 1024, t >> 3, t & 7, e, smem);
    } break;
    case 13:
        for (int it = B; it < NLAT / 4; it += G) modulate_item(p.out, xctx, p.norm2_g + 1024, mod + 17 * 6144, 3 * 1024, 4 * 1024, h, it);
        break;
    case 14: {
        EpiSqRelu e{hid};
        const int nt = (NLAT / 128) * 32;
        for (int t = B; t < nt; t += G) gemm_tile(h, 1024, (const bf16_t*)(ws + OFF_W1) + (size_t)4096 * 1024, 1024, 1024, t >> 5, t & 31, e, smem);
    } break;
    case 15: {
        EpiResid e{p.out, xctx, p.out, xctx, mod + 17 * 6144 + 5 * 1024};
        const int nt = (NLAT / 128) * 8;
        for (int t = B; t < nt; t += G) gemm_tile(hid, 4096, (const bf16_t*)(ws + OFF_W2) + (size_t)1024 * 4096, 4096, 4096, t >> 3, t & 7, e, smem);
    } break;
    case 16:
        for (int it = B; it < NLAT / 4; it += G) finalnorm_item(p.out, p.final_g, it);
        break;
    }
}

#if MK_COOP
__global__ void __launch_bounds__(256, 2) mega_coop(Params p) {
    __shared__ __attribute__((aligned(16))) char smem[SMEM_BYTES];
    cg::grid_group grid = cg::this_grid();
#define PH(n) run_phase(p, n, smem); grid.sync();
    PH(0) PH(1) PH(2) PH(3) PH(4) PH(5) PH(6) PH(7) PH(8) PH(9) PH(10) PH(11) PH(12) PH(13) PH(14) PH(15)
#undef PH
    run_phase(p, 16, smem);
}
#endif
__global__ void __launch_bounds__(256, 2) mega_phase(Params p, int ph) {
    __shared__ __attribute__((aligned(16))) char smem[SMEM_BYTES];
#ifdef ONLY_PH
    run_phase(p, ONLY_PH, smem);
#else
    run_phase(p, ph, smem);
#endif
}

extern "C" void kernel_launch(void* const* d_in, const int* in_sizes, int n_in, void* d_out, int out_size, void* d_ws, size_t ws_size,
                              hipStream_t stream) {
    Params p{};
    const float** f = (const float**)&p;
    for (int i = 0; i < 27; ++i) f[i] = (const float*)d_in[i];
    p.out = (float*)d_out;
    p.ws = (char*)d_ws;
    static int grid_blocks = 0;
    if (!grid_blocks) {
        int dev = 0, cus = 0, per_cu = 0;
        hipGetDevice(&dev);
        hipDeviceGetAttribute(&cus, hipDeviceAttributeMultiprocessorCount, dev);
#if MK_COOP
        hipOccupancyMaxActiveBlocksPerMultiprocessor(&per_cu, mega_coop, 256, 0);
#else
        hipOccupancyMaxActiveBlocksPerMultiprocessor(&per_cu, mega_phase, 256, 0);
#endif
        if (per_cu < 1) per_cu = 1;
        if (per_cu > 2) per_cu = 2;
        grid_blocks = cus * per_cu;
    }
#if MK_COOP
    void* args[] = {&p};
    hipError_t e = hipLaunchCooperativeKernel((void*)mega_coop, dim3(grid_blocks), dim3(256), args, 0, stream);
    if (e != hipSuccess) fprintf(stderr, "cooperative launch failed: %s (grid %d)\n", hipGetErrorString(e), grid_blocks);
#else
    for (int ph = 0; ph < NPHASES; ++ph) mega_phase<<<grid_blocks, 256, 0, stream>>>(p, ph);
#endif
}
```

```cpp
#include <hip/hip_runtime.h>
#include <hip/hip_cooperative_groups.h>
#include <cstdio>
namespace cg = cooperative_groups;

#ifndef MK_COOP
#define MK_COOP 1
#endif

typedef unsigned short bf16_t;
typedef short bf16x8 __attribute__((ext_vector_type(8)));
typedef short bf16x4 __attribute__((ext_vector_type(4)));
typedef float f32x4 __attribute__((ext_vector_type(4)));
typedef unsigned u32x4 __attribute__((ext_vector_type(4)));
typedef unsigned u32x2 __attribute__((ext_vector_type(2)));

#define NLAT 32768
#define NCTX 4096
#define NTOK 36864
#define LK 2304
#define EPSF 1e-6f
#define LOG2_THETA 13.287712379549449f

constexpr size_t al256(size_t x) { return (x + 255) & ~(size_t)255; }
constexpr size_t OFF_EVWIN = 0;
constexpr size_t OFF_ODWIN = OFF_EVWIN + al256((size_t)1792 * 1024 * 2);
constexpr size_t OFF_WOUT = OFF_ODWIN + al256((size_t)1536 * 1024 * 2);
constexpr size_t OFF_W1 = OFF_WOUT + al256((size_t)2 * 1024 * 1024 * 2);
constexpr size_t OFF_W2 = OFF_W1 + al256((size_t)2 * 4096 * 1024 * 2);
constexpr size_t OFF_WUQ = OFF_W2 + al256((size_t)2 * 4096 * 1024 * 2);
constexpr size_t OFF_WUKV = OFF_WUQ + al256((size_t)768 * 256 * 2);
constexpr size_t OFF_SGUW = OFF_WUKV + al256((size_t)1024 * 128 * 2);
constexpr size_t OFF_MOD = OFF_SGUW + al256((size_t)8 * 128 * 128 * 2);
constexpr size_t OFF_SSQ = OFF_MOD + al256((size_t)2 * 17 * 6144 * 4);
constexpr size_t OFF_XCTX = OFF_SSQ + al256((size_t)2 * NTOK * 4);
constexpr size_t OFF_H = OFF_XCTX + al256((size_t)NCTX * 1024 * 4);
constexpr size_t OFF_BIG = OFF_H + al256((size_t)NTOK * 1024 * 2);
constexpr size_t OFF_HID = OFF_BIG;
constexpr size_t OFF_OMIX = OFF_BIG;
constexpr size_t OFF_R = OFF_OMIX + al256((size_t)NTOK * 1024 * 2);
constexpr size_t OFF_Q = OFF_R;
constexpr size_t OFF_QC = OFF_Q + al256((size_t)16 * 8 * 2048 * 64 * 2);
constexpr size_t OFF_K = OFF_QC + al256((size_t)16 * 8 * 256 * 64 * 2);
constexpr size_t OFF_VT = OFF_K + al256((size_t)16 * 2 * LK * 64 * 2);
constexpr size_t OFF_U = OFF_VT + al256((size_t)16 * 2 * LK * 64 * 2);
constexpr size_t OFF_VGT = OFF_U + al256((size_t)NTOK * 512 * 2);
constexpr size_t OFF_CQ = OFF_R;
constexpr size_t OFF_CKV = OFF_CQ + al256((size_t)NTOK * 256 * 2);
constexpr size_t OFF_GLU = OFF_CKV + al256((size_t)NTOK * 128 * 2);
constexpr size_t OFF_Q2 = OFF_GLU + al256((size_t)NTOK * 512 * 2);
constexpr size_t OFF_K2 = OFF_Q2 + al256((size_t)16 * 8 * 2048 * 96 * 2);
constexpr size_t OFF_V2T = OFF_K2 + al256((size_t)16 * 8 * LK * 96 * 2);
constexpr size_t OFF_END1 = OFF_V2T + al256((size_t)16 * 8 * 64 * LK * 2);
constexpr size_t OFF_END = OFF_BIG + al256((size_t)NTOK * 4096 * 2);
static_assert(OFF_END1 <= OFF_END, "layer-1 scratch must fit under hid");

struct Params {
    const float *x, *c, *ctx, *c_ctx, *ada_w, *ada_b, *norm1_g, *norm2_g, *w_out, *mlp_w1, *mlp_w2;
    const float *ev_w_in, *ev_q_norm_g, *ev_k_norm_g, *ev_sgu_norm_g, *ev_sgu_w, *ev_sgu_b;
    const float *od_w_in, *od_q_norm_g, *od_kv_norm_g, *od_w_uq, *od_w_ukv, *od_conv_w, *od_conv_b, *od_ln_g, *od_ln_b, *final_g;
    float* out;
    char* ws;
};

__device__ __forceinline__ unsigned pack_bf16(float lo, float hi) {
    unsigned r;
    asm("v_cvt_pk_bf16_f32 %0, %1, %2" : "=v"(r) : "v"(lo), "v"(hi));
    return r;
}
__device__ __forceinline__ bf16_t f2bf(float f) { return (bf16_t)(pack_bf16(f, 0.f) & 0xffffu); }
__device__ __forceinline__ float bf_lo(unsigned u) { return __uint_as_float(u << 16); }
__device__ __forceinline__ float bf_hi(unsigned u) { return __uint_as_float(u & 0xffff0000u); }
__device__ __forceinline__ void store_bf16x4(bf16_t* p, float a, float b, float c, float d) {
    u32x2 v; v.x = pack_bf16(a, b); v.y = pack_bf16(c, d);
    *(u32x2*)p = v;
}
__device__ __forceinline__ void tokinfo(int row, int& b, int& l, bool& isctx) {
    if (row < NLAT) { b = row >> 11; l = row & 2047; isctx = false; }
    else { int r = row - NLAT; b = r >> 8; l = r & 255; isctx = true; }
}
__device__ __forceinline__ float gelu_tanh(float x) {
    float u = 0.7978845608028654f * (x + 0.044715f * x * x * x);
    return x / (1.f + __expf(-2.f * u));
}
__device__ __forceinline__ float sigmoidf_(float x) { return 1.f / (1.f + __expf(-x)); }
__device__ __forceinline__ void rot(float& x0, float& x1, float ang) {
    float rev = ang * 0.15915494309189535f;
    float s = __builtin_amdgcn_sinf(rev), c = __builtin_amdgcn_cosf(rev);
    float a = x0 * c - x1 * s, b = x0 * s + x1 * c;
    x0 = a; x1 = b;
}

template <class Epi>
__device__ __forceinline__ void gemm_tile(const bf16_t* __restrict__ A, int lda, const bf16_t* __restrict__ Bt, int ldb, int K,
                                          int pm, int pn, const Epi& epi, char* smem) {
    bf16_t* sA = (bf16_t*)smem;
    bf16_t* sB = sA + 128 * 64;
    const int tid = threadIdx.x, lane = tid & 63, w = tid >> 6, wm = w >> 1, wn = w & 1, fr = lane & 15, fq = lane >> 4;
    const int srow = tid >> 3, skc = tid & 7;
    const bf16_t* Ag = A + (size_t)(pm * 128 + srow) * lda + skc * 8;
    const bf16_t* Bg = Bt + (size_t)(pn * 128 + srow) * ldb + skc * 8;
    const int swo = srow * 64 + ((skc ^ ((srow >> 1) & 7)) * 8);
    u32x4 ra[4], rb[4];
    f32x4 acc[4][4];
#pragma unroll
    for (int i = 0; i < 4; ++i)
#pragma unroll
        for (int j = 0; j < 4; ++j) acc[i][j] = (f32x4){0.f, 0.f, 0.f, 0.f};
#pragma unroll
    for (int i = 0; i < 4; ++i) {
        ra[i] = *(const u32x4*)(Ag + (size_t)(32 * i) * lda);
        rb[i] = *(const u32x4*)(Bg + (size_t)(32 * i) * ldb);
    }
    const int nk = K >> 6;
    const int sw = (fr >> 1) & 7;
    for (int kt = 0; kt < nk; ++kt) {
        __syncthreads();
#pragma unroll
        for (int i = 0; i < 4; ++i) {
            *(u32x4*)(sA + swo + i * 32 * 64) = ra[i];
            *(u32x4*)(sB + swo + i * 32 * 64) = rb[i];
        }
        __syncthreads();
        if (kt + 1 < nk) {
#pragma unroll
            for (int i = 0; i < 4; ++i) {
                ra[i] = *(const u32x4*)(Ag + (size_t)(32 * i) * lda + (kt + 1) * 64);
                rb[i] = *(const u32x4*)(Bg + (size_t)(32 * i) * ldb + (kt + 1) * 64);
            }
        }
#pragma unroll
        for (int kk = 0; kk < 2; ++kk) {
            bf16x8 af[4], bfr[4];
            const int co = ((kk * 4 + fq) ^ sw) * 8;
#pragma unroll
            for (int mi = 0; mi < 4; ++mi) af[mi] = *(const bf16x8*)(sA + (wm * 64 + mi * 16 + fr) * 64 + co);
#pragma unroll
            for (int ni = 0; ni < 4; ++ni) bfr[ni] = *(const bf16x8*)(sB + (wn * 64 + ni * 16 + fr) * 64 + co);
#pragma unroll
            for (int mi = 0; mi < 4; ++mi)
#pragma unroll
                for (int ni = 0; ni < 4; ++ni)
                    acc[mi][ni] = __builtin_amdgcn_mfma_f32_16x16x32_bf16(bfr[ni], af[mi], acc[mi][ni], 0, 0, 0);
        }
    }
    epi(acc, pm * 128 + wm * 64, pn * 128 + wn * 64, fr, fq);
}

struct EpiEvenIn {
    bf16_t *Q, *Qc, *K, *Vt, *U, *VgT;
    const float *qg, *kg, *sg;
    __device__ __forceinline__ void operator()(f32x4 (&acc)[4][4], int m0, int n0, int fr, int fq) const {
        if (n0 < 640) {
            const bool isq = n0 < 512;
            const int head = isq ? (n0 >> 6) : ((n0 - 512) >> 6);
            const float* g = isq ? qg : kg;
            f32x4 gv[4];
#pragma unroll
            for (int ni = 0; ni < 4; ++ni) gv[ni] = *(const f32x4*)(g + ni * 16 + 4 * fq);
#pragma unroll
            for (int mi = 0; mi < 4; ++mi) {
                const int row = m0 + mi * 16 + fr;
                int b, l; bool isctx; tokinfo(row, b, l, isctx);
                float ss = 0.f;
#pragma unroll
                for (int ni = 0; ni < 4; ++ni)
#pragma unroll
                    for (int j = 0; j < 4; ++j) ss += acc[mi][ni][j] * acc[mi][ni][j];
                ss += __shfl_xor(ss, 16); ss += __shfl_xor(ss, 32);
                const float r = rsqrtf(ss * (1.f / 64.f) + EPSF);
                bf16_t* dst;
                if (isq) dst = isctx ? Qc + ((size_t)((b * 8 + head) * 256 + l)) * 64 : Q + ((size_t)((b * 8 + head) * 2048 + l)) * 64;
                else dst = K + ((size_t)((b * 2 + head) * LK + (isctx ? l : 256 + l))) * 64;
                const float frow = (float)(l >> 6), fcol = (float)(l & 63);
#pragma unroll
                for (int ni = 0; ni < 4; ++ni) {
                    float v[4];
#pragma unroll
                    for (int j = 0; j < 4; ++j) v[j] = acc[mi][ni][j] * r * gv[ni][j];
                    if (!isctx) {
#pragma unroll
                        for (int p = 0; p < 2; ++p) {
                            const int i = ni * 8 + 2 * fq + p;
                            const float inv = __builtin_amdgcn_exp2f(-(float)(i & 15) * (LOG2_THETA / 16.f));
                            const float ang = (i < 16 ? frow : fcol) * inv;
                            rot(v[2 * p], v[2 * p + 1], ang);
                        }
                    }
                    store_bf16x4(dst + ni * 16 + 4 * fq, v[0], v[1], v[2], v[3]);
                }
            }
        } else if (n0 < 768) {
            const int hk = (n0 - 640) >> 6;
#pragma unroll
            for (int mi = 0; mi < 4; ++mi) {
                const int row = m0 + mi * 16 + fr;
                int b, l; bool isctx; tokinfo(row, b, l, isctx);
                const int pos = isctx ? l : 256 + l;
                bf16_t* dst = Vt + ((size_t)(b * 2 + hk) * 64) * LK + pos;
#pragma unroll
                for (int ni = 0; ni < 4; ++ni)
#pragma unroll
                    for (int j = 0; j < 4; ++j) dst[(size_t)(ni * 16 + 4 * fq + j) * LK] = f2bf(acc[mi][ni][j]);
            }
        } else {
            const int zc = n0 - 768;
            if (zc < 512) {
#pragma unroll
                for (int mi = 0; mi < 4; ++mi) {
                    const int row = m0 + mi * 16 + fr;
#pragma unroll
                    for (int ni = 0; ni < 4; ++ni)
                        store_bf16x4(U + (size_t)row * 512 + zc + ni * 16 + 4 * fq, gelu_tanh(acc[mi][ni][0]), gelu_tanh(acc[mi][ni][1]),
                                     gelu_tanh(acc[mi][ni][2]), gelu_tanh(acc[mi][ni][3]));
                }
            } else {
                const int g = (zc - 512) >> 6;
                f32x4 gv[4];
#pragma unroll
                for (int ni = 0; ni < 4; ++ni) gv[ni] = *(const f32x4*)(sg + g * 64 + ni * 16 + 4 * fq);
#pragma unroll
                for (int mi = 0; mi < 4; ++mi) {
                    const int row = m0 + mi * 16 + fr;
                    float v[4][4];
                    float ss = 0.f;
#pragma unroll
                    for (int ni = 0; ni < 4; ++ni)
#pragma unroll
                        for (int j = 0; j < 4; ++j) { v[ni][j] = gelu_tanh(acc[mi][ni][j]); ss += v[ni][j] * v[ni][j]; }
                    ss += __shfl_xor(ss, 16); ss += __shfl_xor(ss, 32);
                    const float r = rsqrtf(ss * (1.f / 64.f) + EPSF);
                    bf16_t* dst = VgT + ((size_t)(g * 288 + (row >> 7)) * 64) * 128 + (row & 127);
#pragma unroll
                    for (int ni = 0; ni < 4; ++ni)
#pragma unroll
                        for (int j = 0; j < 4; ++j) dst[(size_t)(ni * 16 + 4 * fq + j) * 128] = f2bf(v[ni][j] * r * gv[ni][j]);
                }
            }
        }
    }
};

struct EpiResid {
    const float *xin_lat, *xin_ctx; float *xout_lat, *xout_ctx; const float* gate;
    __device__ __forceinline__ void operator()(f32x4 (&acc)[4][4], int m0, int n0, int fr, int fq) const {
#pragma unroll
        for (int mi = 0; mi < 4; ++mi) {
            const int row = m0 + mi * 16 + fr;
            int b, l; bool isctx; tokinfo(row, b, l, isctx);
            const float* gp = gate + (size_t)(isctx ? 16 : b) * 6144 + n0 + 4 * fq;
            const float* xi = (isctx ? xin_ctx + (size_t)(row - NLAT) * 1024 : xin_lat + (size_t)row * 1024) + n0 + 4 * fq;
            float* xo = (isctx ? xout_ctx + (size_t)(row - NLAT) * 1024 : xout_lat + (size_t)row * 1024) + n0 + 4 * fq;
#pragma unroll
            for (int ni = 0; ni < 4; ++ni) {
                const f32x4 g4 = *(const f32x4*)(gp + ni * 16);
                const f32x4 x4 = *(const f32x4*)(xi + ni * 16);
                *(f32x4*)(xo + ni * 16) = x4 + g4 * acc[mi][ni];
            }
        }
    }
};

struct EpiSqRelu {
    bf16_t* hid;
    __device__ __forceinline__ void operator()(f32x4 (&acc)[4][4], int m0, int n0, int fr, int fq) const {
#pragma unroll
        for (int mi = 0; mi < 4; ++mi) {
            const int row = m0 + mi * 16 + fr;
#pragma unroll
            for (int ni = 0; ni < 4; ++ni) {
                float v[4];
#pragma unroll
                for (int j = 0; j < 4; ++j) { float t = fmaxf(acc[mi][ni][j], 0.f); v[j] = t * t; }
                store_bf16x4(hid + (size_t)row * 4096 + n0 + ni * 16 + 4 * fq, v[0], v[1], v[2], v[3]);
            }
        }
    }
};

struct EpiOddIn {
    bf16_t *CQ, *CKV, *K2, *GLU; float *ssq_q, *ssq_kv;
    __device__ __forceinline__ void operator()(f32x4 (&acc)[4][4], int m0, int n0, int fr, int fq) const {
        if (n0 < 384) {
            const bool isq = n0 < 256;
#pragma unroll
            for (int mi = 0; mi < 4; ++mi) {
                const int row = m0 + mi * 16 + fr;
                float ss = 0.f;
                bf16_t* dst = isq ? CQ + (size_t)row * 256 + n0 : CKV + (size_t)row * 128 + (n0 - 256);
#pragma unroll
                for (int ni = 0; ni < 4; ++ni) {
#pragma unroll
                    for (int j = 0; j < 4; ++j) ss += acc[mi][ni][j] * acc[mi][ni][j];
                    store_bf16x4(dst + ni * 16 + 4 * fq, acc[mi][ni][0], acc[mi][ni][1], acc[mi][ni][2], acc[mi][ni][3]);
                }
                ss += __shfl_xor(ss, 16); ss += __shfl_xor(ss, 32);
                if (fq == 0) atomicAdd((isq ? ssq_q : ssq_kv) + row, ss);
            }
        } else if (n0 < 448) {
#pragma unroll
            for (int mi = 0; mi < 4; ++mi) {
                const int row = m0 + mi * 16 + fr;
                int b, l; bool isctx; tokinfo(row, b, l, isctx);
                const int pos = isctx ? l : 256 + l;
                const float frow = (float)(l >> 6), fcol = (float)(l & 63);
#pragma unroll
                for (int ni = 0; ni < 2; ++ni) {
                    float v[4];
#pragma unroll
                    for (int j = 0; j < 4; ++j) v[j] = acc[mi][ni][j];
                    if (!isctx) {
#pragma unroll
                        for (int p = 0; p < 2; ++p) {
                            const int i = ni * 8 + 2 * fq + p;
                            const float inv = __builtin_amdgcn_exp2f(-(float)(i & 7) * (LOG2_THETA / 8.f));
                            rot(v[2 * p], v[2 * p + 1], (i < 8 ? frow : fcol) * inv);
                        }
                    }
#pragma unroll
                    for (int h = 0; h < 8; ++h)
                        store_bf16x4(K2 + ((size_t)((b * 8 + h) * LK + pos)) * 96 + 64 + ni * 16 + 4 * fq, v[0], v[1], v[2], v[3]);
                }
            }
        } else if (n0 >= 512) {
            const int wt = (n0 - 512) >> 6;
#pragma unroll
            for (int mi = 0; mi < 4; ++mi) {
                const int row = m0 + mi * 16 + fr;
#pragma unroll
                for (int ni = 0; ni < 2; ++ni) {
                    float v[4];
#pragma unroll
                    for (int j = 0; j < 4; ++j) v[j] = acc[mi][ni][j] * sigmoidf_(acc[mi][ni + 2][j]);
                    store_bf16x4(GLU + (size_t)row * 512 + wt * 32 + ni * 16 + 4 * fq, v[0], v[1], v[2], v[3]);
                }
            }
        }
    }
};

struct EpiQUp {
    bf16_t* Q2; const float* ssq_q;
    __device__ __forceinline__ void operator()(f32x4 (&acc)[4][4], int m0, int n0, int fr, int fq) const {
#pragma unroll
        for (int mi = 0; mi < 4; ++mi) {
            const int row = m0 + mi * 16 + fr;
            const int b = row >> 11, l = row & 2047;
            const float r = rsqrtf(ssq_q[row] * (1.f / 256.f) + EPSF);
            const float frow = (float)(l >> 6), fcol = (float)(l & 63);
#pragma unroll
            for (int ni = 0; ni < 4; ++ni) {
                const int col = n0 + ni * 16 + 4 * fq;
                const int h = col / 96, d = col - h * 96;
                float v[4];
#pragma unroll
                for (int j = 0; j < 4; ++j) v[j] = acc[mi][ni][j] * r;
                if (d >= 64) {
#pragma unroll
                    for (int p = 0; p < 2; ++p) {
                        const int i = ((d - 64) >> 1) + p;
                        const float inv = __builtin_amdgcn_exp2f(-(float)(i & 7) * (LOG2_THETA / 8.f));
                        rot(v[2 * p], v[2 * p + 1], (i < 8 ? frow : fcol) * inv);
                    }
                }
                store_bf16x4(Q2 + ((size_t)((b * 8 + h) * 2048 + l)) * 96 + d, v[0], v[1], v[2], v[3]);
            }
        }
    }
};

struct EpiKVUp {
    bf16_t *K2, *V2t; const float* ssq_kv;
    __device__ __forceinline__ void operator()(f32x4 (&acc)[4][4], int m0, int n0, int fr, int fq) const {
        const int h = n0 >> 7;
        const bool isv = (n0 & 64) != 0;
#pragma unroll
        for (int mi = 0; mi < 4; ++mi) {
            const int row = m0 + mi * 16 + fr;
            int b, l; bool isctx; tokinfo(row, b, l, isctx);
            const int pos = isctx ? l : 256 + l;
            const float r = rsqrtf(ssq_kv[row] * (1.f / 128.f) + EPSF);
            if (!isv) {
                bf16_t* dst = K2 + ((size_t)((b * 8 + h) * LK + pos)) * 96;
#pragma unroll
                for (int ni = 0; ni < 4; ++ni)
                    store_bf16x4(dst + ni * 16 + 4 * fq, acc[mi][ni][0] * r, acc[mi][ni][1] * r, acc[mi][ni][2] * r, acc[mi][ni][3] * r);
            } else {
                bf16_t* dst = V2t + ((size_t)(b * 8 + h) * 64) * LK + pos;
#pragma unroll
                for (int ni = 0; ni < 4; ++ni)
#pragma unroll
                    for (int j = 0; j < 4; ++j) dst[(size_t)(ni * 16 + 4 * fq + j) * LK] = f2bf(acc[mi][ni][j] * r);
            }
        }
    }
};

struct EpiGate {
    const bf16_t* U; bf16_t* Omix; const float* bias; int g;
    __device__ __forceinline__ void operator()(f32x4 (&acc)[4][4], int m0, int n0, int fr, int fq) const {
#pragma unroll
        for (int mi = 0; mi < 4; ++mi) {
            const int pp = m0 + mi * 16 + fr;
            const float bs = bias[pp];
#pragma unroll
            for (int ni = 0; ni < 4; ++ni) {
                const int col = n0 + ni * 16 + 4 * fq;
                const int chunk = col >> 6, c = col & 63;
                const size_t tok = (size_t)chunk * 128 + pp;
                const u32x2 u = *(const u32x2*)(U + tok * 512 + g * 64 + c);
                store_bf16x4(Omix + tok * 1024 + 512 + g * 64 + c, (acc[mi][ni][0] + bs) * bf_lo(u.x), (acc[mi][ni][1] + bs) * bf_hi(u.x),
                             (acc[mi][ni][2] + bs) * bf_lo(u.y), (acc[mi][ni][3] + bs) * bf_hi(u.y));
            }
        }
    }
};

template <int DQK>
__device__ __forceinline__ void attn_item(const bf16_t* __restrict__ Qb, const bf16_t* __restrict__ Kb, const bf16_t* __restrict__ Vtb,
                                          bf16_t* __restrict__ Omix, int item, int Lq, int nkeys, int hk_div, int rowbase, float cexp, char* smem) {
    constexpr int KSTR = (DQK == 64) ? 64 : 128;
    constexpr int NDC = DQK / 32;
    constexpr int KCH = DQK / 8;
    constexpr int NKL = KCH / 4;
    bf16_t* sK = (bf16_t*)smem;
    bf16_t* sV = sK + 64 * KSTR;
    const int tid = threadIdx.x, lane = tid & 63, w = tid >> 6, fr = lane & 15, fq = lane >> 4;
    const int nqt = Lq >> 7;
    const int qt = item % nqt, h = (item / nqt) & 7, b = item / (nqt * 8);
    const int nkvh = 8 / hk_div, hk = h / hk_div;
    const bf16_t* Qp = Qb + ((size_t)((b * 8 + h) * Lq + qt * 128 + w * 32)) * DQK;
    const bf16_t* Kp = Kb + (size_t)(b * nkvh + hk) * LK * DQK;
    const bf16_t* Vp = Vtb + (size_t)(b * nkvh + hk) * 64 * LK;

    bf16x8 qf[2][NDC];
#pragma unroll
    for (int qb = 0; qb < 2; ++qb)
#pragma unroll
        for (int dc = 0; dc < NDC; ++dc) qf[qb][dc] = *(const bf16x8*)(Qp + (qb * 16 + fr) * DQK + dc * 32 + fq * 8);

    int koff_g[NKL], koff_s[NKL];
#pragma unroll
    for (int i = 0; i < NKL; ++i) {
        const int c = tid + 256 * i, row = c / KCH, ch = c % KCH;
        koff_g[i] = row * DQK + ch * 8;
        koff_s[i] = (DQK == 64) ? row * 64 + ((ch ^ ((row >> 1) & 7)) * 8) : row * 128 + ((ch ^ (row & 15)) * 8);
    }
    u32x4 rk[NKL], rv[2];
#pragma unroll
    for (int i = 0; i < NKL; ++i) rk[i] = *(const u32x4*)(Kp + koff_g[i]);
#pragma unroll
    for (int i = 0; i < 2; ++i) { const int c = tid + 256 * i; rv[i] = *(const u32x4*)(Vp + (size_t)(c >> 3) * LK + (c & 7) * 8); }

    f32x4 o[2][4];
    float m[2], lsum[2];
#pragma unroll
    for (int qb = 0; qb < 2; ++qb) {
        m[qb] = -1e30f; lsum[qb] = 0.f;
#pragma unroll
        for (int d = 0; d < 4; ++d) o[qb][d] = (f32x4){0.f, 0.f, 0.f, 0.f};
    }
    const int nt = nkeys >> 6;
    for (int kt = 0; kt < nt; ++kt) {
        __syncthreads();
#pragma unroll
        for (int i = 0; i < NKL; ++i) *(u32x4*)(sK + koff_s[i]) = rk[i];
#pragma unroll
        for (int i = 0; i < 2; ++i) { const int c = tid + 256 * i; *(u32x4*)(sV + (c >> 3) * 72 + (c & 7) * 8) = rv[i]; }
        __syncthreads();
        if (kt + 1 < nt) {
#pragma unroll
            for (int i = 0; i < NKL; ++i) rk[i] = *(const u32x4*)(Kp + (size_t)(kt + 1) * 64 * DQK + koff_g[i]);
#pragma unroll
            for (int i = 0; i < 2; ++i) { const int c = tid + 256 * i; rv[i] = *(const u32x4*)(Vp + (size_t)(c >> 3) * LK + (kt + 1) * 64 + (c & 7) * 8); }
        }
        f32x4 s[2][4];
#pragma unroll
        for (int kb = 0; kb < 4; ++kb) {
#pragma unroll
            for (int qb = 0; qb < 2; ++qb) s[qb][kb] = (f32x4){0.f, 0.f, 0.f, 0.f};
#pragma unroll
            for (int dc = 0; dc < NDC; ++dc) {
                const int row = kb * 16 + fr, ch = dc * 4 + fq;
                const int off = (DQK == 64) ? row * 64 + ((ch ^ ((row >> 1) & 7)) * 8) : row * 128 + ((ch ^ (row & 15)) * 8);
                const bf16x8 kf = *(const bf16x8*)(sK + off);
#pragma unroll
                for (int qb = 0; qb < 2; ++qb) s[qb][kb] = __builtin_amdgcn_mfma_f32_16x16x32_bf16(kf, qf[qb][dc], s[qb][kb], 0, 0, 0);
            }
        }
        bf16x8 pb[2][2];
#pragma unroll
        for (int qb = 0; qb < 2; ++qb) {
            float mx = s[qb][0][0];
#pragma unroll
            for (int kb = 0; kb < 4; ++kb)
#pragma unroll
                for (int j = 0; j < 4; ++j) mx = fmaxf(mx, s[qb][kb][j]);
            mx = fmaxf(mx, __shfl_xor(mx, 16)); mx = fmaxf(mx, __shfl_xor(mx, 32));
            const float mnew = fmaxf(m[qb], mx);
            const float alpha = __builtin_amdgcn_exp2f((m[qb] - mnew) * cexp);
            m[qb] = mnew;
            const float mc = mnew * cexp;
            float ps = 0.f;
            unsigned pk[8];
#pragma unroll
            for (int kb = 0; kb < 4; ++kb) {
                float p0 = __builtin_amdgcn_exp2f(s[qb][kb][0] * cexp - mc), p1 = __builtin_amdgcn_exp2f(s[qb][kb][1] * cexp - mc);
                float p2 = __builtin_amdgcn_exp2f(s[qb][kb][2] * cexp - mc), p3 = __builtin_amdgcn_exp2f(s[qb][kb][3] * cexp - mc);
                ps += (p0 + p1) + (p2 + p3);
                pk[kb * 2] = pack_bf16(p0, p1); pk[kb * 2 + 1] = pack_bf16(p2, p3);
            }
            lsum[qb] = lsum[qb] * alpha + ps;
            u32x4 t0 = {pk[0], pk[1], pk[2], pk[3]}, t1 = {pk[4], pk[5], pk[6], pk[7]};
            pb[qb][0] = __builtin_bit_cast(bf16x8, t0);
            pb[qb][1] = __builtin_bit_cast(bf16x8, t1);
#pragma unroll
            for (int d = 0; d < 4; ++d) o[qb][d] *= alpha;
        }
#pragma unroll
        for (int dvb = 0; dvb < 4; ++dvb)
#pragma unroll
            for (int ks = 0; ks < 2; ++ks) {
                const bf16_t* vp = sV + (dvb * 16 + fr) * 72 + ks * 32 + fq * 4;
                const u32x2 v0 = *(const u32x2*)vp, v1 = *(const u32x2*)(vp + 16);
                    u32x4 t = {v0.x, v0.y, v1.x, v1.y};
                const bf16x8 vf = __builtin_bit_cast(bf16x8, t);
#pragma unroll
                for (int qb = 0; qb < 2; ++qb) o[qb][dvb] = __builtin_amdgcn_mfma_f32_16x16x32_bf16(vf, pb[qb][ks], o[qb][dvb], 0, 0, 0);
            }
    }
#pragma unroll
    for (int qb = 0; qb < 2; ++qb) {
        float lt = lsum[qb];
        lt += __shfl_xor(lt, 16); lt += __shfl_xor(lt, 32);
        const float inv = 1.f / lt;
        const size_t row = (size_t)rowbase + (size_t)b * Lq + qt * 128 + w * 32 + qb * 16 + fr;
#pragma unroll
        for (int dvb = 0; dvb < 4; ++dvb)
            store_bf16x4(Omix + row * 1024 + h * 64 + dvb * 16 + fq * 4, o[qb][dvb][0] * inv, o[qb][dvb][1] * inv, o[qb][dvb][2] * inv, o[qb][dvb][3] * inv);
    }
}

__device__ __forceinline__ void conv_item(const bf16_t* __restrict__ GLU, const float* __restrict__ cw, const float* __restrict__ cb,
                                          const float* __restrict__ lg, const float* __restrict__ lb, bf16_t* __restrict__ Omix, int item, char* smem) {
    float* ys = (float*)smem;
    const int tid = threadIdx.x, lane = tid & 63, w = tid >> 6;
    const int ch = 2 * tid;
    const int tok0 = item * 16, b = tok0 >> 11, l0 = tok0 & 2047;
    const bf16_t* gp = GLU + ((size_t)b * 2048) * 512 + ch;
    float w0[31], w1[31];
#pragma unroll
    for (int j = 0; j < 31; ++j) { const float2 t = *(const float2*)(cw + j * 512 + ch); w0[j] = t.x; w1[j] = t.y; }
    const float2 cbv = *(const float2*)(cb + ch);
    unsigned win[31];
#pragma unroll
    for (int j = 0; j < 31; ++j) {
        const int l = l0 - 15 + j;
        win[j] = (l >= 0 && l < 2048) ? *(const unsigned*)(gp + (size_t)l * 512) : 0u;
    }
    __syncthreads();
#pragma unroll 1
    for (int t = 0; t < 16; ++t) {
        float a0 = cbv.x, a1 = cbv.y;
#pragma unroll
        for (int j = 0; j < 31; ++j) { a0 += w0[j] * bf_lo(win[j]); a1 += w1[j] * bf_hi(win[j]); }
        *(float2*)(ys + t * 512 + ch) = make_float2(a0, a1);
        const int l = l0 + t + 16;
        const unsigned nx = (l < 2048) ? *(const unsigned*)(gp + (size_t)l * 512) : 0u;
#pragma unroll
        for (int j = 0; j < 30; ++j) win[j] = win[j + 1];
        win[30] = nx;
    }
    __syncthreads();
#pragma unroll 1
    for (int t = w; t < 16; t += 4) {
        const f32x4 v0 = *(const f32x4*)(ys + t * 512 + lane * 8), v1 = *(const f32x4*)(ys + t * 512 + lane * 8 + 4);
        float sm = (v0[0] + v0[1]) + (v0[2] + v0[3]) + (v1[0] + v1[1]) + (v1[2] + v1[3]);
#pragma unroll
        for (int o = 32; o >= 1; o >>= 1) sm += __shfl_xor(sm, o);
        const float mean = sm * (1.f / 512.f);
        float d[8];
        float sq = 0.f;
#pragma unroll
        for (int j = 0; j < 4; ++j) { d[j] = v0[j] - mean; d[4 + j] = v1[j] - mean; }
#pragma unroll
        for (int j = 0; j < 8; ++j) sq += d[j] * d[j];
#pragma unroll
        for (int o = 32; o >= 1; o >>= 1) sq += __shfl_xor(sq, o);
        const float r = rsqrtf(sq * (1.f / 512.f) + EPSF);
        const f32x4 g0 = *(const f32x4*)(lg + lane * 8), g1 = *(const f32x4*)(lg + lane * 8 + 4);
        const f32x4 b0 = *(const f32x4*)(lb + lane * 8), b1 = *(const f32x4*)(lb + lane * 8 + 4);
        float o_[8];
#pragma unroll
        for (int j = 0; j < 4; ++j) { o_[j] = d[j] * r * g0[j] + b0[j]; o_[4 + j] = d[4 + j] * r * g1[j] + b1[j]; }
#pragma unroll
        for (int j = 0; j < 8; ++j) o_[j] = o_[j] * sigmoidf_(o_[j]);
        u32x4 pk = {pack_bf16(o_[0], o_[1]), pack_bf16(o_[2], o_[3]), pack_bf16(o_[4], o_[5]), pack_bf16(o_[6], o_[7])};
        *(u32x4*)(Omix + (size_t)(tok0 + t) * 1024 + 512 + lane * 8) = pk;
    }
}

__device__ __forceinline__ void modulate_item(const float* __restrict__ xlat, const float* __restrict__ xctx, const float* __restrict__ ng,
                                              const float* __restrict__ modl, int sh_off, int sc_off, bf16_t* __restrict__ h, int item) {
    const int lane = threadIdx.x & 63, w = threadIdx.x >> 6;
    const int row = item * 4 + w;
    int b, l; bool isctx; tokinfo(row, b, l, isctx);
    const float* x = isctx ? xctx + (size_t)(row - NLAT) * 1024 : xlat + (size_t)row * 1024;
    const float* mp = modl + (size_t)(isctx ? 16 : b) * 6144;
    f32x4 v[4];
    float ss = 0.f;
#pragma unroll
    for (int i = 0; i < 4; ++i) {
        v[i] = *(const f32x4*)(x + i * 256 + lane * 4);
        ss += v[i][0] * v[i][0] + v[i][1] * v[i][1] + v[i][2] * v[i][2] + v[i][3] * v[i][3];
    }
#pragma unroll
    for (int o = 32; o >= 1; o >>= 1) ss += __shfl_xor(ss, o);
    const float r = rsqrtf(ss * (1.f / 1024.f) + EPSF);
#pragma unroll
    for (int i = 0; i < 4; ++i) {
        const int col = i * 256 + lane * 4;
        const f32x4 g4 = *(const f32x4*)(ng + col), sc = *(const f32x4*)(mp + sc_off + col), sh = *(const f32x4*)(mp + sh_off + col);
        float y[4];
#pragma unroll
        for (int j = 0; j < 4; ++j) y[j] = v[i][j] * r * g4[j] * (1.f + sc[j]) + sh[j];
        store_bf16x4(h + (size_t)row * 1024 + col, y[0], y[1], y[2], y[3]);
    }
}
__device__ __forceinline__ void finalnorm_item(float* __restrict__ x, const float* __restrict__ g, int item) {
    const int lane = threadIdx.x & 63, w = threadIdx.x >> 6;
    float* xr = x + (size_t)(item * 4 + w) * 1024;
    f32x4 v[4];
    float ss = 0.f;
#pragma unroll
    for (int i = 0; i < 4; ++i) {
        v[i] = *(const f32x4*)(xr + i * 256 + lane * 4);
        ss += v[i][0] * v[i][0] + v[i][1] * v[i][1] + v[i][2] * v[i][2] + v[i][3] * v[i][3];
    }
#pragma unroll
    for (int o = 32; o >= 1; o >>= 1) ss += __shfl_xor(ss, o);
    const float r = rsqrtf(ss * (1.f / 1024.f) + EPSF);
#pragma unroll
    for (int i = 0; i < 4; ++i) {
        const f32x4 g4 = *(const f32x4*)(g + i * 256 + lane * 4);
        *(f32x4*)(xr + i * 256 + lane * 4) = v[i] * r * g4;
    }
}

__device__ __forceinline__ int odmap(int n) {
    if (n < 416) return n;
    if (n < 512) return -1;
    const int t = n - 512, wt = t >> 6, c = t & 63;
    return 416 + (c < 32 ? wt * 32 + c : 512 + wt * 32 + (c - 32));
}
template <bool ODMAP>
__device__ __forceinline__ void tconv_tile(const float* __restrict__ src, int ldsrc, bf16_t* __restrict__ dst, int K, const float* __restrict__ rs,
                                           int tile, char* smem) {
    float* t = (float*)smem;
    const int nkt = K >> 6;
    const int kt = tile % nkt, ntile = tile / nkt;
    const int k0 = kt * 64, n0 = ntile * 64;
    const int tid = threadIdx.x;
    __syncthreads();
    {
        const int n = tid & 63;
        const int sn = ODMAP ? odmap(n0 + n) : n0 + n;
#pragma unroll
        for (int i = 0; i < 16; ++i) {
            const int k = i * 4 + (tid >> 6);
            float v = sn >= 0 ? src[(size_t)(k0 + k) * ldsrc + sn] : 0.f;
            if (rs) v *= rs[k0 + k];
            t[k * 65 + n] = v;
        }
    }
    __syncthreads();
#pragma unroll
    for (int j = 0; j < 2; ++j) {
        const int n = (tid >> 3) + 32 * j, kc = (tid & 7) * 8;
        u32x4 o;
        o.x = pack_bf16(t[(kc + 0) * 65 + n], t[(kc + 1) * 65 + n]);
        o.y = pack_bf16(t[(kc + 2) * 65 + n], t[(kc + 3) * 65 + n]);
        o.z = pack_bf16(t[(kc + 4) * 65 + n], t[(kc + 5) * 65 + n]);
        o.w = pack_bf16(t[(kc + 6) * 65 + n], t[(kc + 7) * 65 + n]);
        *(u32x4*)(dst + (size_t)(n0 + n) * K + k0 + kc) = o;
    }
}
__device__ __forceinline__ void ada_item(const Params& p, float* __restrict__ mod, int item, char* smem) {
    float* s = (float*)smem;
    const int tid = threadIdx.x;
    const int layer = item / 96, n0 = (item % 96) * 64;
    const int col = tid & 63, ks = tid >> 6;
    float acc[17];
#pragma unroll
    for (int r = 0; r < 17; ++r) acc[r] = 0.f;
    for (int half = 0; half < 2; ++half) {
        __syncthreads();
        for (int idx = tid; idx < 17 * 512; idx += 256) {
            const int r = idx >> 9, k = (idx & 511) + half * 512;
            const float v = r < 16 ? p.c[r * 1024 + k] : p.c_ctx[k];
            s[idx] = v * sigmoidf_(v);
        }
        __syncthreads();
        const float* wp = p.ada_w + ((size_t)layer * 1024 + half * 512 + ks * 128) * 6144 + n0 + col;
        for (int k = 0; k < 128; ++k) {
            const float wv = wp[(size_t)k * 6144];
#pragma unroll
            for (int r = 0; r < 17; ++r) acc[r] += s[r * 512 + ks * 128 + k] * wv;
        }
    }
    __syncthreads();
#pragma unroll
    for (int r = 0; r < 17; ++r) s[(ks * 17 + r) * 64 + col] = acc[r];
    __syncthreads();
    for (int idx = tid; idx < 17 * 64; idx += 256) {
        const int r = idx >> 6, cc = idx & 63;
        const float v = s[(0 * 17 + r) * 64 + cc] + s[(1 * 17 + r) * 64 + cc] + s[(2 * 17 + r) * 64 + cc] + s[(3 * 17 + r) * 64 + cc];
        mod[((size_t)layer * 17 + r) * 6144 + n0 + cc] = v + p.ada_b[layer * 6144 + n0 + cc];
    }
}

constexpr int P0_EV = (1792 / 64) * 16;
constexpr int P0_OD = (1536 / 64) * 16;
constexpr int P0_WO = 2 * 16 * 16;
constexpr int P0_W1 = 2 * 64 * 16;
constexpr int P0_W2 = 2 * 16 * 64;
constexpr int P0_UQ = (768 / 64) * 4;
constexpr int P0_UKV = (1024 / 64) * 2;
constexpr int P0_SGU = 128;
constexpr int P0_ZERO = 72;
constexpr int P0_ADA = 192;
constexpr int P0_TOTAL = P0_ADA + P0_EV + P0_OD + P0_WO + P0_W1 + P0_W2 + P0_UQ + P0_UKV + P0_SGU + P0_ZERO;

__device__ __forceinline__ void phase0_item(const Params& p, int it, char* smem) {
    char* ws = p.ws;
    if (it < P0_ADA) { ada_item(p, (float*)(ws + OFF_MOD), it, smem); return; }
    it -= P0_ADA;
    if (it < P0_EV) { tconv_tile<false>(p.ev_w_in, 1792, (bf16_t*)(ws + OFF_EVWIN), 1024, nullptr, it, smem); return; }
    it -= P0_EV;
    if (it < P0_OD) { tconv_tile<true>(p.od_w_in, 1440, (bf16_t*)(ws + OFF_ODWIN), 1024, nullptr, it, smem); return; }
    it -= P0_OD;
    if (it < P0_WO) { const int l = it / 256; tconv_tile<false>(p.w_out + (size_t)l * 1024 * 1024, 1024, (bf16_t*)(ws + OFF_WOUT) + (size_t)l * 1024 * 1024, 1024, nullptr, it % 256, smem); return; }
    it -= P0_WO;
    if (it < P0_W1) { const int l = it / 1024; tconv_tile<false>(p.mlp_w1 + (size_t)l * 1024 * 4096, 4096, (bf16_t*)(ws + OFF_W1) + (size_t)l * 4096 * 1024, 1024, nullptr, it % 1024, smem); return; }
    it -= P0_W1;
    if (it < P0_W2) { const int l = it / 1024; tconv_tile<false>(p.mlp_w2 + (size_t)l * 4096 * 1024, 1024, (bf16_t*)(ws + OFF_W2) + (size_t)l * 1024 * 4096, 4096, nullptr, it % 1024, smem); return; }
    it -= P0_W2;
    if (it < P0_UQ) { tconv_tile<false>(p.od_w_uq, 768, (bf16_t*)(ws + OFF_WUQ), 256, p.od_q_norm_g, it, smem); return; }
    it -= P0_UQ;
    if (it < P0_UKV) { tconv_tile<false>(p.od_w_ukv, 1024, (bf16_t*)(ws + OFF_WUKV), 128, p.od_kv_norm_g, it, smem); return; }
    it -= P0_UKV;
    if (it < P0_SGU) {
        const int e = it * 1024 + threadIdx.x * 4;
        const f32x4 v = *(const f32x4*)(p.ev_sgu_w + e);
        store_bf16x4((bf16_t*)(ws + OFF_SGUW) + e, v[0], v[1], v[2], v[3]);
        return;
    }
    it -= P0_SGU;
    { *(f32x4*)((float*)(ws + OFF_SSQ) + it * 1024 + threadIdx.x * 4) = (f32x4){0.f, 0.f, 0.f, 0.f}; }
}

#define NPHASES 17
#define SMEM_BYTES 34816

__device__ __forceinline__ void run_phase(const Params& p, int ph, char* smem) {
    char* ws = p.ws;
    const int G = gridDim.x, B = blockIdx.x;
    float* mod = (float*)(ws + OFF_MOD);
    float* xctx = (float*)(ws + OFF_XCTX);
    bf16_t* h = (bf16_t*)(ws + OFF_H);
    bf16_t* hid = (bf16_t*)(ws + OFF_HID);
    bf16_t* omix = (bf16_t*)(ws + OFF_OMIX);
    float* ssq_q = (float*)(ws + OFF_SSQ);
    float* ssq_kv = ssq_q + NTOK;
    switch (ph) {
    case 0:
        for (int it = B; it < P0_TOTAL; it += G) phase0_item(p, it, smem);
        break;
    case 1:
        for (int it = B; it < NTOK / 4; it += G) modulate_item(p.x, p.ctx, p.norm1_g, mod, 0, 1024, h, it);
        break;
    case 2: {
        EpiEvenIn e{(bf16_t*)(ws + OFF_Q), (bf16_t*)(ws + OFF_QC), (bf16_t*)(ws + OFF_K), (bf16_t*)(ws + OFF_VT), (bf16_t*)(ws + OFF_U),
                    (bf16_t*)(ws + OFF_VGT), p.ev_q_norm_g, p.ev_k_norm_g, p.ev_sgu_norm_g};
        const int nN = 1792 / 128, nt = (NTOK / 128) * nN;
        for (int t = B; t < nt; t += G) gemm_tile(h, 1024, (const bf16_t*)(ws + OFF_EVWIN), 1024, 1024, t / nN, t % nN, e, smem);
    } break;
    case 3: {
        const int n1 = 16 * 8 * 16, n2 = 16 * 8 * 2, n3 = 8 * 144;
        const float cexp = 0.125f * 1.4426950408889634f;
        for (int it = B; it < n1 + n2 + n3; it += G) {
            if (it < n1) attn_item<64>((const bf16_t*)(ws + OFF_Q), (const bf16_t*)(ws + OFF_K), (const bf16_t*)(ws + OFF_VT), omix, it, 2048, LK, 4, 0, cexp, smem);
            else if (it < n1 + n2) attn_item<64>((const bf16_t*)(ws + OFF_QC), (const bf16_t*)(ws + OFF_K), (const bf16_t*)(ws + OFF_VT), omix, it - n1, 256, 256, 4, NLAT, cexp, smem);
            else {
                const int t = it - n1 - n2, g = t / 144, pn = t % 144;
                EpiGate e{(const bf16_t*)(ws + OFF_U), omix, p.ev_sgu_b + g * 128, g};
                gemm_tile((const bf16_t*)(ws + OFF_SGUW) + g * 16384, 128, (const bf16_t*)(ws + OFF_VGT) + (size_t)g * 288 * 64 * 128, 128, 128, 0, pn, e, smem);
            }
        }
    } break;
    case 4: {
        EpiResid e{p.x, p.ctx, p.out, xctx, mod + 2 * 1024};
        const int nt = (NTOK / 128) * 8;
        for (int t = B; t < nt; t += G) gemm_tile(omix, 1024, (const bf16_t*)(ws + OFF_WOUT), 1024, 1024, t >> 3, t & 7, e, smem);
    } break;
    case 5:
        for (int it = B; it < NTOK / 4; it += G) modulate_item(p.out, xctx, p.norm2_g, mod, 3 * 1024, 4 * 1024, h, it);
        break;
    case 6: {
        EpiSqRelu e{hid};
        const int nt = (NTOK / 128) * 32;
        for (int t = B; t < nt; t += G) gemm_tile(h, 1024, (const bf16_t*)(ws + OFF_W1), 1024, 1024, t >> 5, t & 31, e, smem);
    } break;
    case 7: {
        EpiResid e{p.out, xctx, p.out, xctx, mod + 5 * 1024};
        const int nt = (NTOK / 128) * 8;
        for (int t = B; t < nt; t += G) gemm_tile(hid, 4096, (const bf16_t*)(ws + OFF_W2), 4096, 4096, t >> 3, t & 7, e, smem);
    } break;
    case 8:
        for (int it = B; it < NTOK / 4; it += G) modulate_item(p.out, xctx, p.norm1_g + 1024, mod + 17 * 6144, 0, 1024, h, it);
        break;
    case 9: {
        EpiOddIn e{(bf16_t*)(ws + OFF_CQ), (bf16_t*)(ws + OFF_CKV), (bf16_t*)(ws + OFF_K2), (bf16_t*)(ws + OFF_GLU), ssq_q, ssq_kv};
        const int nN = 12, nt = (NTOK / 128) * nN;
        for (int t = B; t < nt; t += G) gemm_tile(h, 1024, (const bf16_t*)(ws + OFF_ODWIN), 1024, 1024, t / nN, t % nN, e, smem);
    } break;
    case 10: {
        const int n1 = (NLAT / 128) * 6, n2 = (NTOK / 128) * 8, n3 = NLAT / 16;
        EpiQUp eq{(bf16_t*)(ws + OFF_Q2), ssq_q};
        EpiKVUp ek{(bf16_t*)(ws + OFF_K2), (bf16_t*)(ws + OFF_V2T), ssq_kv};
        for (int it = B; it < n1 + n2 + n3; it += G) {
            if (it < n1) gemm_tile((const bf16_t*)(ws + OFF_CQ), 256, (const bf16_t*)(ws + OFF_WUQ), 256, 256, it / 6, it % 6, eq, smem);
            else if (it < n1 + n2) { const int t = it - n1; gemm_tile((const bf16_t*)(ws + OFF_CKV), 128, (const bf16_t*)(ws + OFF_WUKV), 128, 128, t >> 3, t & 7, ek, smem); }
            else conv_item((const bf16_t*)(ws + OFF_GLU), p.od_conv_w, p.od_conv_b, p.od_ln_g, p.od_ln_b, omix, it - n1 - n2, smem);
        }
    } break;
    case 11: {
        const float cexp = 0.10206207261596575f * 1.4426950408889634f;
        for (int it = B; it < 16 * 8 * 16; it += G)
            attn_item<96>((const bf16_t*)(ws + OFF_Q2), (const bf16_t*)(ws + OFF_K2), (const bf16_t*)(ws + OFF_V2T), omix, it, 2048, LK, 1, 0, cexp, smem);
    } break;
    case 12: {
        EpiResid e{p.out, xctx, p.out, xctx, mod + 17 * 6144 + 2 * 1024};
        const int nt = (NLAT / 128) * 8;
        for (int t = B; t < nt; t += G) gemm_tile(omix, 1024, (const bf16_t*)(ws + OFF_WOUT) + 1024 * 1024, 1024, 1024, t >> 3, t & 7, e, smem);
    } break;
    case 13:
        for (int it = B; it < NLAT / 4; it += G) modulate_item(p.out, xctx, p.norm2_g + 1024, mod + 17 * 6144, 3 * 1024, 4 * 1024, h, it);
        break;
    case 14: {
        EpiSqRelu e{hid};
        const int nt = (NLAT / 128) * 32;
        for (int t = B; t < nt; t += G) gemm_tile(h, 1024, (const bf16_t*)(ws + OFF_W1) + (size_t)4096 * 1024, 1024, 1024, t >> 5, t & 31, e, smem);
    } break;
    case 15: {
        EpiResid e{p.out, xctx, p.out, xctx, mod + 17 * 6144 + 5 * 1024};
        const int nt = (NLAT / 128) * 8;
        for (int t = B; t < nt; t += G) gemm_tile(hid, 4096, (const bf16_t*)(ws + OFF_W2) + (size_t)1024 * 4096, 4096, 4096, t >> 3, t & 7, e, smem);
    } break;
    case 16:
        for (int it = B; it < NLAT / 4; it += G) finalnorm_item(p.out, p.final_g, it);
        break;
    }
}

#if MK_COOP
__global__ void __launch_bounds__(256, 2) mega_coop(Params p) {
    __shared__ __attribute__((aligned(16))) char smem[SMEM_BYTES];
    cg::grid_group grid = cg::this_grid();
#define PH(n) run_phase(p, n, smem); grid.sync();
    PH(0) PH(1) PH(2) PH(3) PH(4) PH(5) PH(6) PH(7) PH(8) PH(9) PH(10) PH(11) PH(12) PH(13) PH(14) PH(15)
#undef PH
    run_phase(p, 16, smem);
}
#endif
__global__ void __launch_bounds__(256, 2) mega_phase(Params p, int ph) {
    __shared__ __attribute__((aligned(16))) char smem[SMEM_BYTES];
#ifdef ONLY_PH
    run_phase(p, ONLY_PH, smem);
#else
    run_phase(p, ph, smem);
#endif
}

extern "C" void kernel_launch(void* const* d_in, const int* in_sizes, int n_in, void* d_out, int out_size, void* d_ws, size_t ws_size,
                              hipStream_t stream) {
    Params p{};
    const float** f = (const float**)&p;
    for (int i = 0; i < 27; ++i) f[i] = (const float*)d_in[i];
    p.out = (float*)d_out;
    p.ws = (char*)d_ws;
    static int grid_blocks = 0;
    if (!grid_blocks) {
        int dev = 0, cus = 0, per_cu = 0;
        hipGetDevice(&dev);
        hipDeviceGetAttribute(&cus, hipDeviceAttributeMultiprocessorCount, dev);
#if MK_COOP
        hipOccupancyMaxActiveBlocksPerMultiprocessor(&per_cu, mega_coop, 256, 0);
#else
        hipOccupancyMaxActiveBlocksPerMultiprocessor(&per_cu, mega_phase, 256, 0);
#endif
        if (per_cu < 1) per_cu = 1;
        if (per_cu > 2) per_cu = 2;
        grid_blocks = cus * per_cu;
    }
#if MK_COOP
    void* args[] = {&p};
    hipError_t e = hipLaunchCooperativeKernel((void*)mega_coop, dim3(grid_blocks), dim3(256), args, 0, stream);
    if (e != hipSuccess) fprintf(stderr, "cooperative launch failed: %s (grid %d)\n", hipGetErrorString(e), grid_blocks);
#else
    for (int ph = 0; ph < NPHASES; ++ph) mega_phase<<<grid_blocks, 256, 0, stream>>>(p, ph);
#endif
}
```

```cpp
#include <hip/hip_runtime.h>
#include <hip/hip_cooperative_groups.h>
#include <cstdio>
namespace cg = cooperative_groups;

#ifndef MK_COOP
#define MK_COOP 1
#endif

typedef unsigned short bf16_t;
typedef short bf16x8 __attribute__((ext_vector_type(8)));
typedef short bf16x4 __attribute__((ext_vector_type(4)));
typedef float f32x4 __attribute__((ext_vector_type(4)));
typedef unsigned u32x4 __attribute__((ext_vector_type(4)));
typedef unsigned u32x2 __attribute__((ext_vector_type(2)));

#define NLAT 32768
#define NCTX 4096
#define NTOK 36864
#define LK 2304
#define EPSF 1e-6f
#define LOG2_THETA 13.287712379549449f

constexpr size_t al256(size_t x) { return (x + 255) & ~(size_t)255; }
constexpr size_t OFF_EVWIN = 0;
constexpr size_t OFF_ODWIN = OFF_EVWIN + al256((size_t)1792 * 1024 * 2);
constexpr size_t OFF_WOUT = OFF_ODWIN + al256((size_t)1536 * 1024 * 2);
constexpr size_t OFF_W1 = OFF_WOUT + al256((size_t)2 * 1024 * 1024 * 2);
constexpr size_t OFF_W2 = OFF_W1 + al256((size_t)2 * 4096 * 1024 * 2);
constexpr size_t OFF_WUQ = OFF_W2 + al256((size_t)2 * 4096 * 1024 * 2);
constexpr size_t OFF_WUKV = OFF_WUQ + al256((size_t)768 * 256 * 2);
constexpr size_t OFF_SGUW = OFF_WUKV + al256((size_t)1024 * 128 * 2);
constexpr size_t OFF_MOD = OFF_SGUW + al256((size_t)8 * 128 * 128 * 2);
constexpr size_t OFF_SSQ = OFF_MOD + al256((size_t)2 * 17 * 6144 * 4);
constexpr size_t OFF_XCTX = OFF_SSQ + al256((size_t)2 * NTOK * 4);
constexpr size_t OFF_H = OFF_XCTX + al256((size_t)NCTX * 1024 * 4);
constexpr size_t OFF_BIG = OFF_H + al256((size_t)NTOK * 1024 * 2);
constexpr size_t OFF_HID = OFF_BIG;
constexpr size_t OFF_OMIX = OFF_BIG;
constexpr size_t OFF_R = OFF_OMIX + al256((size_t)NTOK * 1024 * 2);
constexpr size_t OFF_Q = OFF_R;
constexpr size_t OFF_QC = OFF_Q + al256((size_t)16 * 8 * 2048 * 64 * 2);
constexpr size_t OFF_K = OFF_QC + al256((size_t)16 * 8 * 256 * 64 * 2);
constexpr size_t OFF_VT = OFF_K + al256((size_t)16 * 2 * LK * 64 * 2);
constexpr size_t OFF_U = OFF_VT + al256((size_t)16 * 2 * LK * 64 * 2);
constexpr size_t OFF_VGT = OFF_U + al256((size_t)NTOK * 512 * 2);
constexpr size_t OFF_CQ = OFF_R;
constexpr size_t OFF_CKV = OFF_CQ + al256((size_t)NTOK * 256 * 2);
constexpr size_t OFF_GLU = OFF_CKV + al256((size_t)NTOK * 128 * 2);
constexpr size_t OFF_Q2 = OFF_GLU + al256((size_t)NTOK * 512 * 2);
constexpr size_t OFF_K2 = OFF_Q2 + al256((size_t)16 * 8 * 2048 * 96 * 2);
constexpr size_t OFF_V2T = OFF_K2 + al256((size_t)16 * 8 * LK * 96 * 2);
constexpr size_t OFF_END1 = OFF_V2T + al256((size_t)16 * 8 * 64 * LK * 2);
constexpr size_t OFF_END = OFF_BIG + al256((size_t)NTOK * 4096 * 2);
static_assert(OFF_END1 <= OFF_END, "layer-1 scratch must fit under hid");
constexpr size_t OFF_BAR = OFF_END;

struct Params {
    const float *x, *c, *ctx, *c_ctx, *ada_w, *ada_b, *norm1_g, *norm2_g, *w_out, *mlp_w1, *mlp_w2;
    const float *ev_w_in, *ev_q_norm_g, *ev_k_norm_g, *ev_sgu_norm_g, *ev_sgu_w, *ev_sgu_b;
    const float *od_w_in, *od_q_norm_g, *od_kv_norm_g, *od_w_uq, *od_w_ukv, *od_conv_w, *od_conv_b, *od_ln_g, *od_ln_b, *final_g;
    float* out;
    char* ws;
};

__device__ __forceinline__ unsigned pack_bf16(float lo, float hi) {
    unsigned r;
    asm("v_cvt_pk_bf16_f32 %0, %1, %2" : "=v"(r) : "v"(lo), "v"(hi));
    return r;
}
__device__ __forceinline__ bf16_t f2bf(float f) { return (bf16_t)(pack_bf16(f, 0.f) & 0xffffu); }
__device__ __forceinline__ float bf_lo(unsigned u) { return __uint_as_float(u << 16); }
__device__ __forceinline__ float bf_hi(unsigned u) { return __uint_as_float(u & 0xffff0000u); }
__device__ __forceinline__ void store_bf16x4(bf16_t* p, float a, float b, float c, float d) {
    u32x2 v; v.x = pack_bf16(a, b); v.y = pack_bf16(c, d);
    *(u32x2*)p = v;
}
__device__ __forceinline__ void tokinfo(int row, int& b, int& l, bool& isctx) {
    if (row < NLAT) { b = row >> 11; l = row & 2047; isctx = false; }
    else { int r = row - NLAT; b = r >> 8; l = r & 255; isctx = true; }
}
__device__ __forceinline__ float gelu_tanh(float x) {
    float u = 0.7978845608028654f * (x + 0.044715f * x * x * x);
    return x / (1.f + __expf(-2.f * u));
}
__device__ __forceinline__ float sigmoidf_(float x) { return 1.f / (1.f + __expf(-x)); }
__device__ __forceinline__ void rot(float& x0, float& x1, float ang) {
    float rev = ang * 0.15915494309189535f;
    float s = __builtin_amdgcn_sinf(rev), c = __builtin_amdgcn_cosf(rev);
    float a = x0 * c - x1 * s, b = x0 * s + x1 * c;
    x0 = a; x1 = b;
}

template <class Epi>
__device__ __forceinline__ void gemm_tile(const bf16_t* __restrict__ A, int lda, const bf16_t* __restrict__ Bt, int ldb, int K,
                                          int pm, int pn, const Epi& epi, char* smem) {
    bf16_t* sA = (bf16_t*)smem;
    bf16_t* sB = sA + 128 * 64;
    const int tid = threadIdx.x, lane = tid & 63, w = tid >> 6, wm = w >> 1, wn = w & 1, fr = lane & 15, fq = lane >> 4;
    const int srow = tid >> 3, skc = tid & 7;
    const bf16_t* Ag = A + (size_t)(pm * 128 + srow) * lda + skc * 8;
    const bf16_t* Bg = Bt + (size_t)(pn * 128 + srow) * ldb + skc * 8;
    const int swo = srow * 64 + ((skc ^ ((srow >> 1) & 7)) * 8);
    u32x4 ra[4], rb[4];
    f32x4 acc[4][4];
#pragma unroll
    for (int i = 0; i < 4; ++i)
#pragma unroll
        for (int j = 0; j < 4; ++j) acc[i][j] = (f32x4){0.f, 0.f, 0.f, 0.f};
#pragma unroll
    for (int i = 0; i < 4; ++i) {
        ra[i] = *(const u32x4*)(Ag + (size_t)(32 * i) * lda);
        rb[i] = *(const u32x4*)(Bg + (size_t)(32 * i) * ldb);
    }
    const int nk = K >> 6;
    const int sw = (fr >> 1) & 7;
    for (int kt = 0; kt < nk; ++kt) {
        __syncthreads();
#pragma unroll
        for (int i = 0; i < 4; ++i) {
            *(u32x4*)(sA + swo + i * 32 * 64) = ra[i];
            *(u32x4*)(sB + swo + i * 32 * 64) = rb[i];
        }
        __syncthreads();
        if (kt + 1 < nk) {
#pragma unroll
            for (int i = 0; i < 4; ++i) {
                ra[i] = *(const u32x4*)(Ag + (size_t)(32 * i) * lda + (kt + 1) * 64);
                rb[i] = *(const u32x4*)(Bg + (size_t)(32 * i) * ldb + (kt + 1) * 64);
            }
        }
#pragma unroll
        for (int kk = 0; kk < 2; ++kk) {
            bf16x8 af[4], bfr[4];
            const int co = ((kk * 4 + fq) ^ sw) * 8;
#pragma unroll
            for (int mi = 0; mi < 4; ++mi) af[mi] = *(const bf16x8*)(sA + (wm * 64 + mi * 16 + fr) * 64 + co);
#pragma unroll
            for (int ni = 0; ni < 4; ++ni) bfr[ni] = *(const bf16x8*)(sB + (wn * 64 + ni * 16 + fr) * 64 + co);
#pragma unroll
            for (int mi = 0; mi < 4; ++mi)
#pragma unroll
                for (int ni = 0; ni < 4; ++ni)
                    acc[mi][ni] = __builtin_amdgcn_mfma_f32_16x16x32_bf16(bfr[ni], af[mi], acc[mi][ni], 0, 0, 0);
        }
    }
    epi(acc, pm * 128 + wm * 64, pn * 128 + wn * 64, fr, fq);
}

struct EpiEvenIn {
    bf16_t *Q, *Qc, *K, *Vt, *U, *VgT;
    const float *qg, *kg, *sg;
    __device__ __forceinline__ void operator()(f32x4 (&acc)[4][4], int m0, int n0, int fr, int fq) const {
        if (n0 < 640) {
            const bool isq = n0 < 512;
            const int head = isq ? (n0 >> 6) : ((n0 - 512) >> 6);
            const float* g = isq ? qg : kg;
            f32x4 gv[4];
#pragma unroll
            for (int ni = 0; ni < 4; ++ni) gv[ni] = *(const f32x4*)(g + ni * 16 + 4 * fq);
#pragma unroll
            for (int mi = 0; mi < 4; ++mi) {
                const int row = m0 + mi * 16 + fr;
                int b, l; bool isctx; tokinfo(row, b, l, isctx);
                float ss = 0.f;
#pragma unroll
                for (int ni = 0; ni < 4; ++ni)
#pragma unroll
                    for (int j = 0; j < 4; ++j) ss += acc[mi][ni][j] * acc[mi][ni][j];
                ss += __shfl_xor(ss, 16); ss += __shfl_xor(ss, 32);
                const float r = rsqrtf(ss * (1.f / 64.f) + EPSF);
                bf16_t* dst;
                if (isq) dst = isctx ? Qc + ((size_t)((b * 8 + head) * 256 + l)) * 64 : Q + ((size_t)((b * 8 + head) * 2048 + l)) * 64;
                else dst = K + ((size_t)((b * 2 + head) * LK + (isctx ? l : 256 + l))) * 64;
                const float frow = (float)(l >> 6), fcol = (float)(l & 63);
#pragma unroll
                for (int ni = 0; ni < 4; ++ni) {
                    float v[4];
#pragma unroll
                    for (int j = 0; j < 4; ++j) v[j] = acc[mi][ni][j] * r * gv[ni][j];
                    if (!isctx) {
#pragma unroll
                        for (int p = 0; p < 2; ++p) {
                            const int i = ni * 8 + 2 * fq + p;
                            const float inv = __builtin_amdgcn_exp2f(-(float)(i & 15) * (LOG2_THETA / 16.f));
                            const float ang = (i < 16 ? frow : fcol) * inv;
                            rot(v[2 * p], v[2 * p + 1], ang);
                        }
                    }
                    store_bf16x4(dst + ni * 16 + 4 * fq, v[0], v[1], v[2], v[3]);
                }
            }
        } else if (n0 < 768) {
            const int hk = (n0 - 640) >> 6;
#pragma unroll
            for (int mi = 0; mi < 4; ++mi) {
                const int row = m0 + mi * 16 + fr;
                int b, l; bool isctx; tokinfo(row, b, l, isctx);
                const int pos = isctx ? l : 256 + l;
                bf16_t* dst = Vt + ((size_t)(b * 2 + hk) * 64) * LK + pos;
#pragma unroll
                for (int ni = 0; ni < 4; ++ni)
#pragma unroll
                    for (int j = 0; j < 4; ++j) dst[(size_t)(ni * 16 + 4 * fq + j) * LK] = f2bf(acc[mi][ni][j]);
            }
        } else {
            const int zc = n0 - 768;
            if (zc < 512) {
#pragma unroll
                for (int mi = 0; mi < 4; ++mi) {
                    const int row = m0 + mi * 16 + fr;
#pragma unroll
                    for (int ni = 0; ni < 4; ++ni)
                        store_bf16x4(U + (size_t)row * 512 + zc + ni * 16 + 4 * fq, gelu_tanh(acc[mi][ni][0]), gelu_tanh(acc[mi][ni][1]),
                                     gelu_tanh(acc[mi][ni][2]), gelu_tanh(acc[mi][ni][3]));
                }
            } else {
                const int g = (zc - 512) >> 6;
                f32x4 gv[4];
#pragma unroll
                for (int ni = 0; ni < 4; ++ni) gv[ni] = *(const f32x4*)(sg + g * 64 + ni * 16 + 4 * fq);
#pragma unroll
                for (int mi = 0; mi < 4; ++mi) {
                    const int row = m0 + mi * 16 + fr;
                    float v[4][4];
                    float ss = 0.f;
#pragma unroll
                    for (int ni = 0; ni < 4; ++ni)
#pragma unroll
                        for (int j = 0; j < 4; ++j) { v[ni][j] = gelu_tanh(acc[mi][ni][j]); ss += v[ni][j] * v[ni][j]; }
                    ss += __shfl_xor(ss, 16); ss += __shfl_xor(ss, 32);
                    const float r = rsqrtf(ss * (1.f / 64.f) + EPSF);
                    bf16_t* dst = VgT + ((size_t)(g * 288 + (row >> 7)) * 64) * 128 + (row & 127);
#pragma unroll
                    for (int ni = 0; ni < 4; ++ni)
#pragma unroll
                        for (int j = 0; j < 4; ++j) dst[(size_t)(ni * 16 + 4 * fq + j) * 128] = f2bf(v[ni][j] * r * gv[ni][j]);
                }
            }
        }
    }
};

struct EpiResid {
    const float *xin_lat, *xin_ctx; float *xout_lat, *xout_ctx; const float* gate;
    __device__ __forceinline__ void operator()(f32x4 (&acc)[4][4], int m0, int n0, int fr, int fq) const {
#pragma unroll
        for (int mi = 0; mi < 4; ++mi) {
            const int row = m0 + mi * 16 + fr;
            int b, l; bool isctx; tokinfo(row, b, l, isctx);
            const float* gp = gate + (size_t)(isctx ? 16 : b) * 6144 + n0 + 4 * fq;
            const float* xi = (isctx ? xin_ctx + (size_t)(row - NLAT) * 1024 : xin_lat + (size_t)row * 1024) + n0 + 4 * fq;
            float* xo = (isctx ? xout_ctx + (size_t)(row - NLAT) * 1024 : xout_lat + (size_t)row * 1024) + n0 + 4 * fq;
#pragma unroll
            for (int ni = 0; ni < 4; ++ni) {
                const f32x4 g4 = *(const f32x4*)(gp + ni * 16);
                const f32x4 x4 = *(const f32x4*)(xi + ni * 16);
                *(f32x4*)(xo + ni * 16) = x4 + g4 * acc[mi][ni];
            }
        }
    }
};

struct EpiSqRelu {
    bf16_t* hid;
    __device__ __forceinline__ void operator()(f32x4 (&acc)[4][4], int m0, int n0, int fr, int fq) const {
#pragma unroll
        for (int mi = 0; mi < 4; ++mi) {
            const int row = m0 + mi * 16 + fr;
#pragma unroll
            for (int ni = 0; ni < 4; ++ni) {
                float v[4];
#pragma unroll
                for (int j = 0; j < 4; ++j) { float t = fmaxf(acc[mi][ni][j], 0.f); v[j] = t * t; }
                store_bf16x4(hid + (size_t)row * 4096 + n0 + ni * 16 + 4 * fq, v[0], v[1], v[2], v[3]);
            }
        }
    }
};

struct EpiOddIn {
    bf16_t *CQ, *CKV, *K2, *GLU; float *ssq_q, *ssq_kv;
    __device__ __forceinline__ void operator()(f32x4 (&acc)[4][4], int m0, int n0, int fr, int fq) const {
        if (n0 < 384) {
            const bool isq = n0 < 256;
#pragma unroll
            for (int mi = 0; mi < 4; ++mi) {
                const int row = m0 + mi * 16 + fr;
                float ss = 0.f;
                bf16_t* dst = isq ? CQ + (size_t)row * 256 + n0 : CKV + (size_t)row * 128 + (n0 - 256);
#pragma unroll
                for (int ni = 0; ni < 4; ++ni) {
#pragma unroll
                    for (int j = 0; j < 4; ++j) ss += acc[mi][ni][j] * acc[mi][ni][j];
                    store_bf16x4(dst + ni * 16 + 4 * fq, acc[mi][ni][0], acc[mi][ni][1], acc[mi][ni][2], acc[mi][ni][3]);
                }
                ss += __shfl_xor(ss, 16); ss += __shfl_xor(ss, 32);
                if (fq == 0) atomicAdd((isq ? ssq_q : ssq_kv) + row, ss);
            }
        } else if (n0 < 448) {
#pragma unroll
            for (int mi = 0; mi < 4; ++mi) {
                const int row = m0 + mi * 16 + fr;
                int b, l; bool isctx; tokinfo(row, b, l, isctx);
                const int pos = isctx ? l : 256 + l;
                const float frow = (float)(l >> 6), fcol = (float)(l & 63);
#pragma unroll
                for (int ni = 0; ni < 2; ++ni) {
                    float v[4];
#pragma unroll
                    for (int j = 0; j < 4; ++j) v[j] = acc[mi][ni][j];
                    if (!isctx) {
#pragma unroll
                        for (int p = 0; p < 2; ++p) {
                            const int i = ni * 8 + 2 * fq + p;
                            const float inv = __builtin_amdgcn_exp2f(-(float)(i & 7) * (LOG2_THETA / 8.f));
                            rot(v[2 * p], v[2 * p + 1], (i < 8 ? frow : fcol) * inv);
                        }
                    }
#pragma unroll
                    for (int h = 0; h < 8; ++h)
                        store_bf16x4(K2 + ((size_t)((b * 8 + h) * LK + pos)) * 96 + 64 + ni * 16 + 4 * fq, v[0], v[1], v[2], v[3]);
                }
            }
        } else if (n0 >= 512) {
            const int wt = (n0 - 512) >> 6;
#pragma unroll
            for (int mi = 0; mi < 4; ++mi) {
                const int row = m0 + mi * 16 + fr;
#pragma unroll
                for (int ni = 0; ni < 2; ++ni) {
                    float v[4];
#pragma unroll
                    for (int j = 0; j < 4; ++j) v[j] = acc[mi][ni][j] * sigmoidf_(acc[mi][ni + 2][j]);
                    store_bf16x4(GLU + (size_t)row * 512 + wt * 32 + ni * 16 + 4 * fq, v[0], v[1], v[2], v[3]);
                }
            }
        }
    }
};

struct EpiQUp {
    bf16_t* Q2; const float* ssq_q;
    __device__ __forceinline__ void operator()(f32x4 (&acc)[4][4], int m0, int n0, int fr, int fq) const {
#pragma unroll
        for (int mi = 0; mi < 4; ++mi) {
            const int row = m0 + mi * 16 + fr;
            const int b = row >> 11, l = row & 2047;
            const float r = rsqrtf(ssq_q[row] * (1.f / 256.f) + EPSF);
            const float frow = (float)(l >> 6), fcol = (float)(l & 63);
#pragma unroll
            for (int ni = 0; ni < 4; ++ni) {
                const int col = n0 + ni * 16 + 4 * fq;
                const int h = col / 96, d = col - h * 96;
                float v[4];
#pragma unroll
                for (int j = 0; j < 4; ++j) v[j] = acc[mi][ni][j] * r;
                if (d >= 64) {
#pragma unroll
                    for (int p = 0; p < 2; ++p) {
                        const int i = ((d - 64) >> 1) + p;
                        const float inv = __builtin_amdgcn_exp2f(-(float)(i & 7) * (LOG2_THETA / 8.f));
                        rot(v[2 * p], v[2 * p + 1], (i < 8 ? frow : fcol) * inv);
                    }
                }
                store_bf16x4(Q2 + ((size_t)((b * 8 + h) * 2048 + l)) * 96 + d, v[0], v[1], v[2], v[3]);
            }
        }
    }
};

struct EpiKVUp {
    bf16_t *K2, *V2t; const float* ssq_kv;
    __device__ __forceinline__ void operator()(f32x4 (&acc)[4][4], int m0, int n0, int fr, int fq) const {
        const int h = n0 >> 7;
        const bool isv = (n0 & 64) != 0;
#pragma unroll
        for (int mi = 0; mi < 4; ++mi) {
            const int row = m0 + mi * 16 + fr;
            int b, l; bool isctx; tokinfo(row, b, l, isctx);
            const int pos = isctx ? l : 256 + l;
            const float r = rsqrtf(ssq_kv[row] * (1.f / 128.f) + EPSF);
            if (!isv) {
                bf16_t* dst = K2 + ((size_t)((b * 8 + h) * LK + pos)) * 96;
#pragma unroll
                for (int ni = 0; ni < 4; ++ni)
                    store_bf16x4(dst + ni * 16 + 4 * fq, acc[mi][ni][0] * r, acc[mi][ni][1] * r, acc[mi][ni][2] * r, acc[mi][ni][3] * r);
            } else {
                bf16_t* dst = V2t + ((size_t)(b * 8 + h) * 64) * LK + pos;
#pragma unroll
                for (int ni = 0; ni < 4; ++ni)
#pragma unroll
                    for (int j = 0; j < 4; ++j) dst[(size_t)(ni * 16 + 4 * fq + j) * LK] = f2bf(acc[mi][ni][j] * r);
            }
        }
    }
};

struct EpiGate {
    const bf16_t* U; bf16_t* Omix; const float* bias; int g;
    __device__ __forceinline__ void operator()(f32x4 (&acc)[4][4], int m0, int n0, int fr, int fq) const {
#pragma unroll
        for (int mi = 0; mi < 4; ++mi) {
            const int pp = m0 + mi * 16 + fr;
            const float bs = bias[pp];
#pragma unroll
            for (int ni = 0; ni < 4; ++ni) {
                const int col = n0 + ni * 16 + 4 * fq;
                const int chunk = col >> 6, c = col & 63;
                const size_t tok = (size_t)chunk * 128 + pp;
                const u32x2 u = *(const u32x2*)(U + tok * 512 + g * 64 + c);
                store_bf16x4(Omix + tok * 1024 + 512 + g * 64 + c, (acc[mi][ni][0] + bs) * bf_lo(u.x), (acc[mi][ni][1] + bs) * bf_hi(u.x),
                             (acc[mi][ni][2] + bs) * bf_lo(u.y), (acc[mi][ni][3] + bs) * bf_hi(u.y));
            }
        }
    }
};

template <int DQK>
__device__ __forceinline__ void attn_item(const bf16_t* __restrict__ Qb, const bf16_t* __restrict__ Kb, const bf16_t* __restrict__ Vtb,
                                          bf16_t* __restrict__ Omix, int item, int Lq, int nkeys, int hk_div, int rowbase, float cexp, char* smem) {
    constexpr int KSTR = (DQK == 64) ? 64 : 128;
    constexpr int NDC = DQK / 32;
    constexpr int KCH = DQK / 8;
    constexpr int NKL = KCH / 4;
    bf16_t* sK = (bf16_t*)smem;
    bf16_t* sV = sK + 64 * KSTR;
    const int tid = threadIdx.x, lane = tid & 63, w = tid >> 6, fr = lane & 15, fq = lane >> 4;
    const int nqt = Lq >> 7;
    const int qt = item % nqt, h = (item / nqt) & 7, b = item / (nqt * 8);
    const int nkvh = 8 / hk_div, hk = h / hk_div;
    const bf16_t* Qp = Qb + ((size_t)((b * 8 + h) * Lq + qt * 128 + w * 32)) * DQK;
    const bf16_t* Kp = Kb + (size_t)(b * nkvh + hk) * LK * DQK;
    const bf16_t* Vp = Vtb + (size_t)(b * nkvh + hk) * 64 * LK;

    bf16x8 qf[2][NDC];
#pragma unroll
    for (int qb = 0; qb < 2; ++qb)
#pragma unroll
        for (int dc = 0; dc < NDC; ++dc) qf[qb][dc] = *(const bf16x8*)(Qp + (qb * 16 + fr) * DQK + dc * 32 + fq * 8);

    int koff_g[NKL], koff_s[NKL];
#pragma unroll
    for (int i = 0; i < NKL; ++i) {
        const int c = tid + 256 * i, row = c / KCH, ch = c % KCH;
        koff_g[i] = row * DQK + ch * 8;
        koff_s[i] = (DQK == 64) ? row * 64 + ((ch ^ ((row >> 1) & 7)) * 8) : row * 128 + ((ch ^ (row & 15)) * 8);
    }
    u32x4 rk[NKL], rv[2];
#pragma unroll
    for (int i = 0; i < NKL; ++i) rk[i] = *(const u32x4*)(Kp + koff_g[i]);
#pragma unroll
    for (int i = 0; i < 2; ++i) { const int c = tid + 256 * i; rv[i] = *(const u32x4*)(Vp + (size_t)(c >> 3) * LK + (c & 7) * 8); }

    f32x4 o[2][4];
    float m[2], lsum[2];
#pragma unroll
    for (int qb = 0; qb < 2; ++qb) {
        m[qb] = -1e30f; lsum[qb] = 0.f;
#pragma unroll
        for (int d = 0; d < 4; ++d) o[qb][d] = (f32x4){0.f, 0.f, 0.f, 0.f};
    }
    const int nt = nkeys >> 6;
    for (int kt = 0; kt < nt; ++kt) {
        __syncthreads();
#pragma unroll
        for (int i = 0; i < NKL; ++i) *(u32x4*)(sK + koff_s[i]) = rk[i];
#pragma unroll
        for (int i = 0; i < 2; ++i) { const int c = tid + 256 * i; *(u32x4*)(sV + (c >> 3) * 72 + (c & 7) * 8) = rv[i]; }
        __syncthreads();
        if (kt + 1 < nt) {
#pragma unroll
            for (int i = 0; i < NKL; ++i) rk[i] = *(const u32x4*)(Kp + (size_t)(kt + 1) * 64 * DQK + koff_g[i]);
#pragma unroll
            for (int i = 0; i < 2; ++i) { const int c = tid + 256 * i; rv[i] = *(const u32x4*)(Vp + (size_t)(c >> 3) * LK + (kt + 1) * 64 + (c & 7) * 8); }
        }
        f32x4 s[2][4];
#pragma unroll
        for (int kb = 0; kb < 4; ++kb) {
#pragma unroll
            for (int qb = 0; qb < 2; ++qb) s[qb][kb] = (f32x4){0.f, 0.f, 0.f, 0.f};
#pragma unroll
            for (int dc = 0; dc < NDC; ++dc) {
                const int row = kb * 16 + fr, ch = dc * 4 + fq;
                const int off = (DQK == 64) ? row * 64 + ((ch ^ ((row >> 1) & 7)) * 8) : row * 128 + ((ch ^ (row & 15)) * 8);
                const bf16x8 kf = *(const bf16x8*)(sK + off);
#pragma unroll
                for (int qb = 0; qb < 2; ++qb) s[qb][kb] = __builtin_amdgcn_mfma_f32_16x16x32_bf16(kf, qf[qb][dc], s[qb][kb], 0, 0, 0);
            }
        }
        bf16x8 pb[2][2];
#pragma unroll
        for (int qb = 0; qb < 2; ++qb) {
            float mx = s[qb][0][0];
#pragma unroll
            for (int kb = 0; kb < 4; ++kb)
#pragma unroll
                for (int j = 0; j < 4; ++j) mx = fmaxf(mx, s[qb][kb][j]);
            mx = fmaxf(mx, __shfl_xor(mx, 16)); mx = fmaxf(mx, __shfl_xor(mx, 32));
            const float mnew = fmaxf(m[qb], mx);
            const float alpha = __builtin_amdgcn_exp2f((m[qb] - mnew) * cexp);
            m[qb] = mnew;
            const float mc = mnew * cexp;
            float ps = 0.f;
            unsigned pk[8];
#pragma unroll
            for (int kb = 0; kb < 4; ++kb) {
                float p0 = __builtin_amdgcn_exp2f(s[qb][kb][0] * cexp - mc), p1 = __builtin_amdgcn_exp2f(s[qb][kb][1] * cexp - mc);
                float p2 = __builtin_amdgcn_exp2f(s[qb][kb][2] * cexp - mc), p3 = __builtin_amdgcn_exp2f(s[qb][kb][3] * cexp - mc);
                ps += (p0 + p1) + (p2 + p3);
                pk[kb * 2] = pack_bf16(p0, p1); pk[kb * 2 + 1] = pack_bf16(p2, p3);
            }
            lsum[qb] = lsum[qb] * alpha + ps;
            u32x4 t0 = {pk[0], pk[1], pk[2], pk[3]}, t1 = {pk[4], pk[5], pk[6], pk[7]};
            pb[qb][0] = __builtin_bit_cast(bf16x8, t0);
            pb[qb][1] = __builtin_bit_cast(bf16x8, t1);
#pragma unroll
            for (int d = 0; d < 4; ++d) o[qb][d] *= alpha;
        }
#pragma unroll
        for (int dvb = 0; dvb < 4; ++dvb)
#pragma unroll
            for (int ks = 0; ks < 2; ++ks) {
                const bf16_t* vp = sV + (dvb * 16 + fr) * 72 + ks * 32 + fq * 4;
                const u32x2 v0 = *(const u32x2*)vp, v1 = *(const u32x2*)(vp + 16);
                    u32x4 t = {v0.x, v0.y, v1.x, v1.y};
                const bf16x8 vf = __builtin_bit_cast(bf16x8, t);
#pragma unroll
                for (int qb = 0; qb < 2; ++qb) o[qb][dvb] = __builtin_amdgcn_mfma_f32_16x16x32_bf16(vf, pb[qb][ks], o[qb][dvb], 0, 0, 0);
            }
    }
#pragma unroll
    for (int qb = 0; qb < 2; ++qb) {
        float lt = lsum[qb];
        lt += __shfl_xor(lt, 16); lt += __shfl_xor(lt, 32);
        const float inv = 1.f / lt;
        const size_t row = (size_t)rowbase + (size_t)b * Lq + qt * 128 + w * 32 + qb * 16 + fr;
#pragma unroll
        for (int dvb = 0; dvb < 4; ++dvb)
            store_bf16x4(Omix + row * 1024 + h * 64 + dvb * 16 + fq * 4, o[qb][dvb][0] * inv, o[qb][dvb][1] * inv, o[qb][dvb][2] * inv, o[qb][dvb][3] * inv);
    }
}

__device__ __forceinline__ void conv_item(const bf16_t* __restrict__ GLU, const float* __restrict__ cw, const float* __restrict__ cb,
                                          const float* __restrict__ lg, const float* __restrict__ lb, bf16_t* __restrict__ Omix, int item, char* smem) {
    float* ys = (float*)smem;
    const int tid = threadIdx.x, lane = tid & 63, w = tid >> 6;
    const int ch = 2 * tid;
    const int tok0 = item * 16, b = tok0 >> 11, l0 = tok0 & 2047;
    const bf16_t* gp = GLU + ((size_t)b * 2048) * 512 + ch;
    float w0[31], w1[31];
#pragma unroll
    for (int j = 0; j < 31; ++j) { const float2 t = *(const float2*)(cw + j * 512 + ch); w0[j] = t.x; w1[j] = t.y; }
    const float2 cbv = *(const float2*)(cb + ch);
    unsigned win[31];
#pragma unroll
    for (int j = 0; j < 31; ++j) {
        const int l = l0 - 15 + j;
        win[j] = (l >= 0 && l < 2048) ? *(const unsigned*)(gp + (size_t)l * 512) : 0u;
    }
    __syncthreads();
#pragma unroll 1
    for (int t = 0; t < 16; ++t) {
        float a0 = cbv.x, a1 = cbv.y;
#pragma unroll
        for (int j = 0; j < 31; ++j) { a0 += w0[j] * bf_lo(win[j]); a1 += w1[j] * bf_hi(win[j]); }
        *(float2*)(ys + t * 512 + ch) = make_float2(a0, a1);
        const int l = l0 + t + 16;
        const unsigned nx = (l < 2048) ? *(const unsigned*)(gp + (size_t)l * 512) : 0u;
#pragma unroll
        for (int j = 0; j < 30; ++j) win[j] = win[j + 1];
        win[30] = nx;
    }
    __syncthreads();
#pragma unroll 1
    for (int t = w; t < 16; t += 4) {
        const f32x4 v0 = *(const f32x4*)(ys + t * 512 + lane * 8), v1 = *(const f32x4*)(ys + t * 512 + lane * 8 + 4);
        float sm = (v0[0] + v0[1]) + (v0[2] + v0[3]) + (v1[0] + v1[1]) + (v1[2] + v1[3]);
#pragma unroll
        for (int o = 32; o >= 1; o >>= 1) sm += __shfl_xor(sm, o);
        const float mean = sm * (1.f / 512.f);
        float d[8];
        float sq = 0.f;
#pragma unroll
        for (int j = 0; j < 4; ++j) { d[j] = v0[j] - mean; d[4 + j] = v1[j] - mean; }
#pragma unroll
        for (int j = 0; j < 8; ++j) sq += d[j] * d[j];
#pragma unroll
        for (int o = 32; o >= 1; o >>= 1) sq += __shfl_xor(sq, o);
        const float r = rsqrtf(sq * (1.f / 512.f) + EPSF);
        const f32x4 g0 = *(const f32x4*)(lg + lane * 8), g1 = *(const f32x4*)(lg + lane * 8 + 4);
        const f32x4 b0 = *(const f32x4*)(lb + lane * 8), b1 = *(const f32x4*)(lb + lane * 8 + 4);
        float o_[8];
#pragma unroll
        for (int j = 0; j < 4; ++j) { o_[j] = d[j] * r * g0[j] + b0[j]; o_[4 + j] = d[4 + j] * r * g1[j] + b1[j]; }
#pragma unroll
        for (int j = 0; j < 8; ++j) o_[j] = o_[j] * sigmoidf_(o_[j]);
        u32x4 pk = {pack_bf16(o_[0], o_[1]), pack_bf16(o_[2], o_[3]), pack_bf16(o_[4], o_[5]), pack_bf16(o_[6], o_[7])};
        *(u32x4*)(Omix + (size_t)(tok0 + t) * 1024 + 512 + lane * 8) = pk;
    }
}

__device__ __forceinline__ void modulate_item(const float* __restrict__ xlat, const float* __restrict__ xctx, const float* __restrict__ ng,
                                              const float* __restrict__ modl, int sh_off, int sc_off, bf16_t* __restrict__ h, int item) {
    const int lane = threadIdx.x & 63, w = threadIdx.x >> 6;
    const int row = item * 4 + w;
    int b, l; bool isctx; tokinfo(row, b, l, isctx);
    const float* x = isctx ? xctx + (size_t)(row - NLAT) * 1024 : xlat + (size_t)row * 1024;
    const float* mp = modl + (size_t)(isctx ? 16 : b) * 6144;
    f32x4 v[4];
    float ss = 0.f;
#pragma unroll
    for (int i = 0; i < 4; ++i) {
        v[i] = *(const f32x4*)(x + i * 256 + lane * 4);
        ss += v[i][0] * v[i][0] + v[i][1] * v[i][1] + v[i][2] * v[i][2] + v[i][3] * v[i][3];
    }
#pragma unroll
    for (int o = 32; o >= 1; o >>= 1) ss += __shfl_xor(ss, o);
    const float r = rsqrtf(ss * (1.f / 1024.f) + EPSF);
#pragma unroll
    for (int i = 0; i < 4; ++i) {
        const int col = i * 256 + lane * 4;
        const f32x4 g4 = *(const f32x4*)(ng + col), sc = *(const f32x4*)(mp + sc_off + col), sh = *(const f32x4*)(mp + sh_off + col);
        float y[4];
#pragma unroll
        for (int j = 0; j < 4; ++j) y[j] = v[i][j] * r * g4[j] * (1.f + sc[j]) + sh[j];
        store_bf16x4(h + (size_t)row * 1024 + col, y[0], y[1], y[2], y[3]);
    }
}
__device__ __forceinline__ void finalnorm_item(float* __restrict__ x, const float* __restrict__ g, int item) {
    const int lane = threadIdx.x & 63, w = threadIdx.x >> 6;
    float* xr = x + (size_t)(item * 4 + w) * 1024;
    f32x4 v[4];
    float ss = 0.f;
#pragma unroll
    for (int i = 0; i < 4; ++i) {
        v[i] = *(const f32x4*)(xr + i * 256 + lane * 4);
        ss += v[i][0] * v[i][0] + v[i][1] * v[i][1] + v[i][2] * v[i][2] + v[i][3] * v[i][3];
    }
#pragma unroll
    for (int o = 32; o >= 1; o >>= 1) ss += __shfl_xor(ss, o);
    const float r = rsqrtf(ss * (1.f / 1024.f) + EPSF);
#pragma unroll
    for (int i = 0; i < 4; ++i) {
        const f32x4 g4 = *(const f32x4*)(g + i * 256 + lane * 4);
        *(f32x4*)(xr + i * 256 + lane * 4) = v[i] * r * g4;
    }
}

__device__ __forceinline__ int odmap(int n) {
    if (n < 416) return n;
    if (n < 512) return -1;
    const int t = n - 512, wt = t >> 6, c = t & 63;
    return 416 + (c < 32 ? wt * 32 + c : 512 + wt * 32 + (c - 32));
}
template <bool ODMAP>
__device__ __forceinline__ void tconv_tile(const float* __restrict__ src, int ldsrc, bf16_t* __restrict__ dst, int K, const float* __restrict__ rs,
                                           int tile, char* smem) {
    float* t = (float*)smem;
    const int nkt = K >> 6;
    const int kt = tile % nkt, ntile = tile / nkt;
    const int k0 = kt * 64, n0 = ntile * 64;
    const int tid = threadIdx.x;
    __syncthreads();
    {
        const int n = tid & 63;
        const int sn = ODMAP ? odmap(n0 + n) : n0 + n;
#pragma unroll
        for (int i = 0; i < 16; ++i) {
            const int k = i * 4 + (tid >> 6);
            float v = sn >= 0 ? src[(size_t)(k0 + k) * ldsrc + sn] : 0.f;
            if (rs) v *= rs[k0 + k];
            t[k * 65 + n] = v;
        }
    }
    __syncthreads();
#pragma unroll
    for (int j = 0; j < 2; ++j) {
        const int n = (tid >> 3) + 32 * j, kc = (tid & 7) * 8;
        u32x4 o;
        o.x = pack_bf16(t[(kc + 0) * 65 + n], t[(kc + 1) * 65 + n]);
        o.y = pack_bf16(t[(kc + 2) * 65 + n], t[(kc + 3) * 65 + n]);
        o.z = pack_bf16(t[(kc + 4) * 65 + n], t[(kc + 5) * 65 + n]);
        o.w = pack_bf16(t[(kc + 6) * 65 + n], t[(kc + 7) * 65 + n]);
        *(u32x4*)(dst + (size_t)(n0 + n) * K + k0 + kc) = o;
    }
}
__device__ __forceinline__ void ada_item(const Params& p, float* __restrict__ mod, int item, char* smem) {
    float* s = (float*)smem;
    const int tid = threadIdx.x;
    const int layer = item / 96, n0 = (item % 96) * 64;
    const int col = tid & 63, ks = tid >> 6;
    float acc[17];
#pragma unroll
    for (int r = 0; r < 17; ++r) acc[r] = 0.f;
    for (int half = 0; half < 2; ++half) {
        __syncthreads();
        for (int idx = tid; idx < 17 * 512; idx += 256) {
            const int r = idx >> 9, k = (idx & 511) + half * 512;
            const float v = r < 16 ? p.c[r * 1024 + k] : p.c_ctx[k];
            s[idx] = v * sigmoidf_(v);
        }
        __syncthreads();
        const float* wp = p.ada_w + ((size_t)layer * 1024 + half * 512 + ks * 128) * 6144 + n0 + col;
        for (int k = 0; k < 128; ++k) {
            const float wv = wp[(size_t)k * 6144];
#pragma unroll
            for (int r = 0; r < 17; ++r) acc[r] += s[r * 512 + ks * 128 + k] * wv;
        }
    }
    __syncthreads();
#pragma unroll
    for (int r = 0; r < 17; ++r) s[(ks * 17 + r) * 64 + col] = acc[r];
    __syncthreads();
    for (int idx = tid; idx < 17 * 64; idx += 256) {
        const int r = idx >> 6, cc = idx & 63;
        const float v = s[(0 * 17 + r) * 64 + cc] + s[(1 * 17 + r) * 64 + cc] + s[(2 * 17 + r) * 64 + cc] + s[(3 * 17 + r) * 64 + cc];
        mod[((size_t)layer * 17 + r) * 6144 + n0 + cc] = v + p.ada_b[layer * 6144 + n0 + cc];
    }
}

constexpr int P0_EV = (1792 / 64) * 16;
constexpr int P0_OD = (1536 / 64) * 16;
constexpr int P0_WO = 2 * 16 * 16;
constexpr int P0_W1 = 2 * 64 * 16;
constexpr int P0_W2 = 2 * 16 * 64;
constexpr int P0_UQ = (768 / 64) * 4;
constexpr int P0_UKV = (1024 / 64) * 2;
constexpr int P0_SGU = 128;
constexpr int P0_ZERO = 72;
constexpr int P0_ADA = 192;
constexpr int P0_TOTAL = P0_ADA + P0_EV + P0_OD + P0_WO + P0_W1 + P0_W2 + P0_UQ + P0_UKV + P0_SGU + P0_ZERO;

__device__ __forceinline__ void phase0_item(const Params& p, int it, char* smem) {
    char* ws = p.ws;
    if (it < P0_ADA) { ada_item(p, (float*)(ws + OFF_MOD), it, smem); return; }
    it -= P0_ADA;
    if (it < P0_EV) { tconv_tile<false>(p.ev_w_in, 1792, (bf16_t*)(ws + OFF_EVWIN), 1024, nullptr, it, smem); return; }
    it -= P0_EV;
    if (it < P0_OD) { tconv_tile<true>(p.od_w_in, 1440, (bf16_t*)(ws + OFF_ODWIN), 1024, nullptr, it, smem); return; }
    it -= P0_OD;
    if (it < P0_WO) { const int l = it / 256; tconv_tile<false>(p.w_out + (size_t)l * 1024 * 1024, 1024, (bf16_t*)(ws + OFF_WOUT) + (size_t)l * 1024 * 1024, 1024, nullptr, it % 256, smem); return; }
    it -= P0_WO;
    if (it < P0_W1) { const int l = it / 1024; tconv_tile<false>(p.mlp_w1 + (size_t)l * 1024 * 4096, 4096, (bf16_t*)(ws + OFF_W1) + (size_t)l * 4096 * 1024, 1024, nullptr, it % 1024, smem); return; }
    it -= P0_W1;
    if (it < P0_W2) { const int l = it / 1024; tconv_tile<false>(p.mlp_w2 + (size_t)l * 4096 * 1024, 1024, (bf16_t*)(ws + OFF_W2) + (size_t)l * 1024 * 4096, 4096, nullptr, it % 1024, smem); return; }
    it -= P0_W2;
    if (it < P0_UQ) { tconv_tile<false>(p.od_w_uq, 768, (bf16_t*)(ws + OFF_WUQ), 256, p.od_q_norm_g, it, smem); return; }
    it -= P0_UQ;
    if (it < P0_UKV) { tconv_tile<false>(p.od_w_ukv, 1024, (bf16_t*)(ws + OFF_WUKV), 128, p.od_kv_norm_g, it, smem); return; }
    it -= P0_UKV;
    if (it < P0_SGU) {
        const int e = it * 1024 + threadIdx.x * 4;
        const f32x4 v = *(const f32x4*)(p.ev_sgu_w + e);
        store_bf16x4((bf16_t*)(ws + OFF_SGUW) + e, v[0], v[1], v[2], v[3]);
        return;
    }
    it -= P0_SGU;
    { *(f32x4*)((float*)(ws + OFF_SSQ) + it * 1024 + threadIdx.x * 4) = (f32x4){0.f, 0.f, 0.f, 0.f}; }
}

#define XB_TMO      128
#define XB_XCNT(j)  (256  + 64 * (j))
#define XB_XSUB(j)  (1280 + 64 * (j))
#define XB_XGEN(j)  (2304 + 64 * (j))
#define XB_TOP      3328
#define XB_TOPGEN   3392
#define XCD_BAR_WORDS 3456
#define XB_SPIN_CAP (1u << 20)
#define LAS __attribute__((address_space(3)))
__device__ __forceinline__ unsigned xb_ld(unsigned* p)              { return __hip_atomic_load(p, __ATOMIC_RELAXED, __HIP_MEMORY_SCOPE_AGENT); }
__device__ __forceinline__ unsigned xb_add(unsigned* p, unsigned v) { return __hip_atomic_fetch_add(p, v, __ATOMIC_RELAXED, __HIP_MEMORY_SCOPE_AGENT); }
__device__ __forceinline__ unsigned xb_xcc_id() { return (unsigned)__builtin_amdgcn_s_getreg((3 << 11) | 20) & 0xFu; }
#define XB_SPIN(cond, bar) do { unsigned _sp = 0; while (cond) { __builtin_amdgcn_s_sleep(1); \
    if ((++_sp & 255u) == 0u) { if (xb_ld(&(bar)[XB_TMO])) break; if (_sp > XB_SPIN_CAP) { atomicAdd(&(bar)[XB_TMO], 1u); break; } } } } while (0)
struct XcdBarrier { unsigned* bar; unsigned x; volatile LAS unsigned* st; };
__device__ __forceinline__ XcdBarrier xcd_barrier_post(unsigned* bar, volatile LAS unsigned* st) {
    XcdBarrier b; b.bar = bar; b.x = xb_xcc_id(); b.st = st;
    if (threadIdx.x == 0) (void)xb_add(&bar[XB_XCNT(b.x)], 1u);
    return b;
}
__device__ __forceinline__ void xcd_barrier_complete(unsigned* bar, unsigned x, unsigned& nloc, unsigned& nx) {
    const unsigned G = gridDim.x * gridDim.y * gridDim.z;
    unsigned sum, cnt, mine, sp = 0u;
    for (;;) {
        sum = 0u; cnt = 0u; mine = 0u;
#pragma unroll
        for (unsigned j = 0; j < 16; ++j) { const unsigned c = xb_ld(&bar[XB_XCNT(j)]); sum += c; cnt += (c > 0u) ? 1u : 0u; mine = (j == x) ? c : mine; }
        if (sum == G) break;
        __builtin_amdgcn_s_sleep(1);
        if ((++sp & 255u) == 0u) { if (xb_ld(&bar[XB_TMO])) break; if (sp > XB_SPIN_CAP) { atomicAdd(&bar[XB_TMO], 1u); break; } }
    }
    nloc = mine > 0u ? mine : 1u; nx = cnt > 0u ? cnt : 1u;
}
__device__ __forceinline__ void xcd_barrier(const XcdBarrier& b) {
    asm volatile("s_waitcnt vmcnt(0)" ::: "memory");
    __syncthreads();
    if (threadIdx.x == 0) {
        unsigned* bar = b.bar;
        __builtin_amdgcn_s_waitcnt(0);
        unsigned nloc = b.st[0], nx = b.st[1];
        if (nloc == 0u) { xcd_barrier_complete(bar, b.x, nloc, nx); b.st[0] = nloc; b.st[1] = nx; }
        const unsigned old = xb_add(&bar[XB_XSUB(b.x)], 1u);
        const unsigned gen = old / nloc;
        if (old + 1u == (gen + 1u) * nloc) {
            __builtin_amdgcn_fence(__ATOMIC_RELEASE, "agent");
            asm volatile("s_waitcnt vmcnt(0)" ::: "memory");
            const unsigned og = xb_add(&bar[XB_TOP], 1u);
            const unsigned tg = og / nx;
            if (og + 1u == (tg + 1u) * nx) xb_add(&bar[XB_TOPGEN], 1u);
            else XB_SPIN(xb_ld(&bar[XB_TOPGEN]) == tg, bar);
            __builtin_amdgcn_fence(__ATOMIC_ACQUIRE, "agent");
            xb_add(&bar[XB_XGEN(b.x)], 1u);
            asm volatile("s_waitcnt vmcnt(0)" ::: "memory");
        } else {
            XB_SPIN(xb_ld(&bar[XB_XGEN(b.x)]) == gen, bar);
            __builtin_amdgcn_fence(__ATOMIC_ACQUIRE, "agent");
            asm volatile("s_waitcnt vmcnt(0)" ::: "memory");
        }
    }
    __syncthreads();
}

#define NPHASES 17
#define SMEM_BYTES 34816

__device__ __forceinline__ void run_phase(const Params& p, int ph, char* smem) {
    char* ws = p.ws;
    const int G = gridDim.x, B = blockIdx.x;
    float* mod = (float*)(ws + OFF_MOD);
    float* xctx = (float*)(ws + OFF_XCTX);
    bf16_t* h = (bf16_t*)(ws + OFF_H);
    bf16_t* hid = (bf16_t*)(ws + OFF_HID);
    bf16_t* omix = (bf16_t*)(ws + OFF_OMIX);
    float* ssq_q = (float*)(ws + OFF_SSQ);
    float* ssq_kv = ssq_q + NTOK;
    switch (ph) {
    case 0:
        for (int it = B; it < P0_TOTAL; it += G) phase0_item(p, it, smem);
        break;
    case 1:
        for (int it = B; it < NTOK / 4; it += G) modulate_item(p.x, p.ctx, p.norm1_g, mod, 0, 1024, h, it);
        break;
    case 2: {
        EpiEvenIn e{(bf16_t*)(ws + OFF_Q), (bf16_t*)(ws + OFF_QC), (bf16_t*)(ws + OFF_K), (bf16_t*)(ws + OFF_VT), (bf16_t*)(ws + OFF_U),
                    (bf16_t*)(ws + OFF_VGT), p.ev_q_norm_g, p.ev_k_norm_g, p.ev_sgu_norm_g};
        const int nN = 1792 / 128, nt = (NTOK / 128) * nN;
        for (int t = B; t < nt; t += G) gemm_tile(h, 1024, (const bf16_t*)(ws + OFF_EVWIN), 1024, 1024, t / nN, t % nN, e, smem);
    } break;
    case 3: {
        const int n1 = 16 * 8 * 16, n2 = 16 * 8 * 2, n3 = 8 * 144;
        const float cexp = 0.125f * 1.4426950408889634f;
        for (int it = B; it < n1 + n2 + n3; it += G) {
            if (it < n1) attn_item<64>((const bf16_t*)(ws + OFF_Q), (const bf16_t*)(ws + OFF_K), (const bf16_t*)(ws + OFF_VT), omix, it, 2048, LK, 4, 0, cexp, smem);
            else if (it < n1 + n2) attn_item<64>((const bf16_t*)(ws + OFF_QC), (const bf16_t*)(ws + OFF_K), (const bf16_t*)(ws + OFF_VT), omix, it - n1, 256, 256, 4, NLAT, cexp, smem);
            else {
                const int t = it - n1 - n2, g = t / 144, pn = t % 144;
                EpiGate e{(const bf16_t*)(ws + OFF_U), omix, p.ev_sgu_b + g * 128, g};
                gemm_tile((const bf16_t*)(ws + OFF_SGUW) + g * 16384, 128, (const bf16_t*)(ws + OFF_VGT) + (size_t)g * 288 * 64 * 128, 128, 128, 0, pn, e, smem);
            }
        }
    } break;
    case 4: {
        EpiResid e{p.x, p.ctx, p.out, xctx, mod + 2 * 1024};
        const int nt = (NTOK / 128) * 8;
        for (int t = B; t < nt; t += G) gemm_tile(omix, 1024, (const bf16_t*)(ws + OFF_WOUT), 1024, 1024, t >> 3, t & 7, e, smem);
    } break;
    case 5:
        for (int it = B; it < NTOK / 4; it += G) modulate_item(p.out, xctx, p.norm2_g, mod, 3 * 1024, 4 * 1024, h, it);
        break;
    case 6: {
        EpiSqRelu e{hid};
        const int nt = (NTOK / 128) * 32;
        for (int t = B; t < nt; t += G) gemm_tile(h, 1024, (const bf16_t*)(ws + OFF_W1), 1024, 1024, t >> 5, t & 31, e, smem);
    } break;
    case 7: {
        EpiResid e{p.out, xctx, p.out, xctx, mod + 5 * 1024};
        const int nt = (NTOK / 128) * 8;
        for (int t = B; t < nt; t += G) gemm_tile(hid, 4096, (const bf16_t*)(ws + OFF_W2), 4096, 4096, t >> 3, t & 7, e, smem);
    } break;
    case 8:
        for (int it = B; it < NTOK / 4; it += G) modulate_item(p.out, xctx, p.norm1_g + 1024, mod + 17 * 6144, 0, 1024, h, it);
        break;
    case 9: {
        EpiOddIn e{(bf16_t*)(ws + OFF_CQ), (bf16_t*)(ws + OFF_CKV), (bf16_t*)(ws + OFF_K2), (bf16_t*)(ws + OFF_GLU), ssq_q, ssq_kv};
        const int nN = 12, nt = (NTOK / 128) * nN;
        for (int t = B; t < nt; t += G) gemm_tile(h, 1024, (const bf16_t*)(ws + OFF_ODWIN), 1024, 1024, t / nN, t % nN, e, smem);
    } break;
    case 10: {
        const int n1 = (NLAT / 128) * 6, n2 = (NTOK / 128) * 8, n3 = NLAT / 16;
        EpiQUp eq{(bf16_t*)(ws + OFF_Q2), ssq_q};
        EpiKVUp ek{(bf16_t*)(ws + OFF_K2), (bf16_t*)(ws + OFF_V2T), ssq_kv};
        for (int it = B; it < n1 + n2 + n3; it += G) {
            if (it < n1) gemm_tile((const bf16_t*)(ws + OFF_CQ), 256, (const bf16_t*)(ws + OFF_WUQ), 256, 256, it / 6, it % 6, eq, smem);
            else if (it < n1 + n2) { const int t = it - n1; gemm_tile((const bf16_t*)(ws + OFF_CKV), 128, (const bf16_t*)(ws + OFF_WUKV), 128, 128, t >> 3, t & 7, ek, smem); }
            else conv_item((const bf16_t*)(ws + OFF_GLU), p.od_conv_w, p.od_conv_b, p.od_ln_g, p.od_ln_b, omix, it - n1 - n2, smem);
        }
    } break;
    case 11: {
        const float cexp = 0.10206207261596575f * 1.4426950408889634f;
        for (int it = B; it < 16 * 8 * 16; it += G)
            attn_item<96>((const bf16_t*)(ws + OFF_Q2), (const bf16_t*)(ws + OFF_K2), (const bf16_t*)(ws + OFF_V2T), omix, it, 2048, LK, 1, 0, cexp, smem);
    } break;
    case 12: {
        EpiResid e{p.out, xctx, p.out, xctx, mod + 17 * 6144 + 2 * 1024};
        const int nt = (NLAT / 128) * 8;
        for (int t = B; t < nt; t += G) gemm_tile(omix, 1024, (const bf16_t*)(ws + OFF_WOUT) + 1024 * 1024, 1024, 1024, t >> 3, t & 7, e, smem);
    } break;
    case 13:
        for (int it = B; it < NLAT / 4; it += G) modulate_item(p.out, xctx, p.norm2_g + 1024, mod + 17 * 6144, 3 * 1024, 4 * 1024, h, it);
        break;
    case 14: {
        EpiSqRelu e{hid};
        const int nt = (NLAT / 128) * 32;
        for (int t = B; t < nt; t += G) gemm_tile(h, 1024, (const bf16_t*)(ws + OFF_W1) + (size_t)4096 * 1024, 1024, 1024, t >> 5, t & 31, e, smem);
    } break;
    case 15: {
        EpiResid e{p.out, xctx, p.out, xctx, mod + 17 * 6144 + 5 * 1024};
        const int nt = (NLAT / 128) * 8;
        for (int t = B; t < nt; t += G) gemm_tile(hid, 4096, (const bf16_t*)(ws + OFF_W2) + (size_t)1024 * 4096, 4096, 4096, t >> 3, t & 7, e, smem);
    } break;
    case 16:
        for (int it = B; it < NLAT / 4; it += G) finalnorm_item(p.out, p.final_g, it);
        break;
    }
}

#if MK_COOP
__global__ void __launch_bounds__(256, 2) mega_coop(Params p) {
    __shared__ __attribute__((aligned(16))) char smem[SMEM_BYTES];
    __shared__ u32x4 xb_words;
    cg::grid_group grid = cg::this_grid();
    if (threadIdx.x == 0) xb_words = (u32x4){0u, 0u, 0u, 0u};
    __syncthreads();
    XcdBarrier xb = xcd_barrier_post((unsigned*)(p.ws + OFF_BAR), (volatile LAS unsigned*)&xb_words);
    run_phase(p, 0, smem);
    grid.sync();
#define PH(n) run_phase(p, n, smem); xcd_barrier(xb);
    PH(1) PH(2) PH(3) PH(4) PH(5) PH(6) PH(7) PH(8) PH(9) PH(10) PH(11) PH(12) PH(13) PH(14) PH(15)
#undef PH
    run_phase(p, 16, smem);
}
#endif
__global__ void __launch_bounds__(256, 2) mega_phase(Params p, int ph) {
    __shared__ __attribute__((aligned(16))) char smem[SMEM_BYTES];
#ifdef ONLY_PH
    run_phase(p, ONLY_PH, smem);
#else
    run_phase(p, ph, smem);
#endif
}

extern "C" void kernel_launch(void* const* d_in, const int* in_sizes, int n_in, void* d_out, int out_size, void* d_ws, size_t ws_size,
                              hipStream_t stream) {
    Params p{};
    const float** f = (const float**)&p;
    for (int i = 0; i < 27; ++i) f[i] = (const float*)d_in[i];
    p.out = (float*)d_out;
    p.ws = (char*)d_ws;
    static int grid_blocks = 0;
    if (!grid_blocks) {
        int dev = 0, cus = 0, per_cu = 0;
        hipGetDevice(&dev);
        hipDeviceGetAttribute(&cus, hipDeviceAttributeMultiprocessorCount, dev);
#if MK_COOP
        hipOccupancyMaxActiveBlocksPerMultiprocessor(&per_cu, mega_coop, 256, 0);
#else
        hipOccupancyMaxActiveBlocksPerMultiprocessor(&per_cu, mega_phase, 256, 0);
#endif
        if (per_cu < 1) per_cu = 1;
        if (per_cu > 2) per_cu = 2;
        grid_blocks = cus * per_cu;
    }
#if MK_COOP
    (void)hipMemsetAsync((char*)d_ws + OFF_BAR, 0, XCD_BAR_WORDS * 4, stream);
    void* args[] = {&p};
    hipError_t e = hipLaunchCooperativeKernel((void*)mega_coop, dim3(grid_blocks), dim3(256), args, 0, stream);
    if (e != hipSuccess) fprintf(stderr, "cooperative launch failed: %s (grid %d)\n", hipGetErrorString(e), grid_blocks);
#else
    for (int ph = 0; ph < NPHASES; ++ph) mega_phase<<<grid_blocks, 256, 0, stream>>>(p, ph);
#endif
}
```

```cpp
#include <hip/hip_runtime.h>
#include <hip/hip_cooperative_groups.h>
#include <cstdio>
namespace cg = cooperative_groups;

#ifndef MK_COOP
#define MK_COOP 1
#endif

typedef unsigned short bf16_t;
typedef short bf16x8 __attribute__((ext_vector_type(8)));
typedef short bf16x4 __attribute__((ext_vector_type(4)));
typedef float f32x4 __attribute__((ext_vector_type(4)));
typedef unsigned u32x4 __attribute__((ext_vector_type(4)));
typedef unsigned u32x2 __attribute__((ext_vector_type(2)));

__device__ __forceinline__ unsigned fresh_tid() { unsigned t = threadIdx.x; asm volatile("" : "+v"(t)); return t; }
#define VTID ((int)(fresh_tid() & 255u))
#define NLAT 32768
#define NCTX 4096
#define NTOK 36864
#define LK 2304
#define EPSF 1e-6f
#define LOG2_THETA 13.287712379549449f

constexpr size_t al256(size_t x) { return (x + 255) & ~(size_t)255; }
constexpr size_t OFF_EVWIN = 0;
constexpr size_t OFF_ODWIN = OFF_EVWIN + al256((size_t)1792 * 1024 * 2);
constexpr size_t OFF_WOUT = OFF_ODWIN + al256((size_t)1536 * 1024 * 2);
constexpr size_t OFF_W1 = OFF_WOUT + al256((size_t)2 * 1024 * 1024 * 2);
constexpr size_t OFF_W2 = OFF_W1 + al256((size_t)2 * 4096 * 1024 * 2);
constexpr size_t OFF_WUQ = OFF_W2 + al256((size_t)2 * 4096 * 1024 * 2);
constexpr size_t OFF_WUKV = OFF_WUQ + al256((size_t)768 * 256 * 2);
constexpr size_t OFF_SGUW = OFF_WUKV + al256((size_t)1024 * 128 * 2);
constexpr size_t OFF_MOD = OFF_SGUW + al256((size_t)8 * 128 * 128 * 2);
constexpr size_t OFF_SSQ = OFF_MOD + al256((size_t)2 * 17 * 6144 * 4);
constexpr size_t OFF_BIAS = OFF_SSQ + al256((size_t)5 * NTOK * 16 * 4);
constexpr size_t OFF_XCTX = OFF_BIAS + al256((size_t)17 * (4096 + 1536 + 4096) * 4);
constexpr size_t OFF_H = OFF_XCTX + al256((size_t)NCTX * 1024 * 4);
constexpr size_t OFF_BIG = OFF_H + al256((size_t)NTOK * 1024 * 2);
constexpr size_t OFF_HID = OFF_BIG;
constexpr size_t OFF_OMIX = OFF_BIG;
constexpr size_t OFF_R = OFF_OMIX + al256((size_t)NTOK * 1024 * 2);
constexpr size_t OFF_Q = OFF_R;
constexpr size_t OFF_QC = OFF_Q + al256((size_t)16 * 8 * 2048 * 64 * 2);
constexpr size_t OFF_K = OFF_QC + al256((size_t)16 * 8 * 256 * 64 * 2);
constexpr size_t OFF_VT = OFF_K + al256((size_t)16 * 2 * LK * 64 * 2);
constexpr size_t OFF_U = OFF_VT + al256((size_t)16 * 2 * LK * 64 * 2);
constexpr size_t OFF_VGT = OFF_U + al256((size_t)NTOK * 512 * 2);
constexpr size_t OFF_CQ = OFF_R;
constexpr size_t OFF_CKV = OFF_CQ + al256((size_t)NTOK * 256 * 2);
constexpr size_t OFF_GLU = OFF_CKV + al256((size_t)NTOK * 128 * 2);
constexpr size_t OFF_Q2 = OFF_GLU + al256((size_t)NTOK * 512 * 2);
constexpr size_t OFF_K2 = OFF_Q2 + al256((size_t)16 * 8 * 2048 * 96 * 2);
constexpr size_t OFF_V2T = OFF_K2 + al256((size_t)16 * 8 * LK * 96 * 2);
constexpr size_t OFF_END1 = OFF_V2T + al256((size_t)16 * 8 * 64 * LK * 2);
constexpr size_t OFF_END = OFF_BIG + al256((size_t)NTOK * 4096 * 2);
static_assert(OFF_END1 <= OFF_END, "layer-1 scratch must fit under hid");
constexpr size_t OFF_BAR = OFF_END;
constexpr size_t OFF_WUP = OFF_BAR + 32768;
constexpr size_t OFF_PART = OFF_WUP + al256((size_t)1792 * 384 * 2);

struct Params {
    const float *x, *c, *ctx, *c_ctx, *ada_w, *ada_b, *norm1_g, *norm2_g, *w_out, *mlp_w1, *mlp_w2;
    const float *ev_w_in, *ev_q_norm_g, *ev_k_norm_g, *ev_sgu_norm_g, *ev_sgu_w, *ev_sgu_b;
    const float *od_w_in, *od_q_norm_g, *od_kv_norm_g, *od_w_uq, *od_w_ukv, *od_conv_w, *od_conv_b, *od_ln_g, *od_ln_b, *final_g;
    float* out;
    char* ws;
};

typedef __bf16 bf16x2_n __attribute__((ext_vector_type(2)));
typedef float f32x2_n __attribute__((ext_vector_type(2)));
__device__ __forceinline__ unsigned pack_bf16(float lo, float hi) {
    const f32x2_n v = {lo, hi};
    return __builtin_bit_cast(unsigned, __builtin_convertvector(v, bf16x2_n));
}
__device__ __forceinline__ bf16_t f2bf(float f) { return (bf16_t)(pack_bf16(f, 0.f) & 0xffffu); }
__device__ __forceinline__ float bf_lo(unsigned u) { return __uint_as_float(u << 16); }
__device__ __forceinline__ float bf_hi(unsigned u) { return __uint_as_float(u & 0xffff0000u); }
__device__ __forceinline__ void store_bf16x4(bf16_t* p, float a, float b, float c, float d) {
    u32x2 v; v.x = pack_bf16(a, b); v.y = pack_bf16(c, d);
    *(u32x2*)p = v;
}
__device__ __forceinline__ void store_bf16x4_nt(bf16_t* p, float a, float b, float c, float d) {
    u32x2 v; v.x = pack_bf16(a, b); v.y = pack_bf16(c, d);
    __builtin_nontemporal_store(v, (u32x2*)p);
}
__device__ __forceinline__ void store_f32x4_nt(float* p, f32x4 v) { __builtin_nontemporal_store(v, (f32x4*)p); }
__device__ __forceinline__ void tokinfo(int row, int& b, int& l, bool& isctx) {
    if (row < NLAT) { b = row >> 11; l = row & 2047; isctx = false; }
    else { int r = row - NLAT; b = r >> 8; l = r & 255; isctx = true; }
}
__device__ __forceinline__ float gelu_tanh(float x) {
    float u = 0.7978845608028654f * (x + 0.044715f * x * x * x);
    return x * __builtin_amdgcn_rcpf(1.f + __expf(-2.f * u));
}
__device__ __forceinline__ float sigmoidf_(float x) { return __builtin_amdgcn_rcpf(1.f + __expf(-x)); }
__device__ __forceinline__ void rot(float& x0, float& x1, float ang) {
    float rev = ang * 0.15915494309189535f;
    float s = __builtin_amdgcn_sinf(rev), c = __builtin_amdgcn_cosf(rev);
    float a = x0 * c - x1 * s, b = x0 * s + x1 * c;
    x0 = a; x1 = b;
}

__device__ __forceinline__ float ssq_sum(const float* __restrict__ p, int row, int nslots) {
    const f32x4* q = (const f32x4*)(p + (size_t)row * 16);
    f32x4 t = q[0];
    if (nslots > 4) { t += q[1]; t += q[2]; t += q[3]; }
    float s = t[0] + t[1];
    if (nslots > 2) s += t[2] + t[3];
    return s;
}

__device__ __forceinline__ float dpp_xor1(float x) { return __int_as_float(__builtin_amdgcn_update_dpp(0, __float_as_int(x), 0xB1, 0xf, 0xf, false)); }
__device__ __forceinline__ float dpp_xor2(float x) { return __int_as_float(__builtin_amdgcn_update_dpp(0, __float_as_int(x), 0x4E, 0xf, 0xf, false)); }
__device__ __forceinline__ void quad_transpose(float (&v)[4], int lane) {
    const bool odd = (lane & 1) != 0, hi = (lane & 2) != 0;
    const float sa = odd ? v[0] : v[1], sb = odd ? v[2] : v[3];
    const float ra = dpp_xor1(sa), rb = dpp_xor1(sb);
    const float n0 = odd ? ra : v[0], n1 = odd ? v[1] : ra, n2 = odd ? rb : v[2], n3 = odd ? v[3] : rb;
    const float ta = hi ? n0 : n2, tb = hi ? n1 : n3;
    const float ua = dpp_xor2(ta), ub = dpp_xor2(tb);
    v[0] = hi ? ua : n0; v[1] = hi ? ub : n1; v[2] = hi ? n2 : ua; v[3] = hi ? n3 : ub;
}

template <class Epi>
__device__ __forceinline__ void gemm_tile(const bf16_t* __restrict__ A, int lda, const bf16_t* __restrict__ Bt, int ldb, int K,
                                          int pm, int pn, const Epi& epi, char* smem) {
    bf16_t* sA = (bf16_t*)smem;
    bf16_t* sB = sA + 128 * 64;
    const int tid = VTID, lane = tid & 63, w = tid >> 6, wm = w >> 1, wn = w & 1, fr = lane & 15, fq = lane >> 4;
    const int srow = tid >> 3, skc = tid & 7;
    const bf16_t* Ag = A + (size_t)(pm * 128 + srow) * lda + skc * 8;
    const bf16_t* Bg = Bt + (size_t)(pn * 128 + srow) * ldb + skc * 8;
    const int swo = srow * 64 + ((skc ^ ((srow >> 1) & 7)) * 8);
    u32x4 ra[4], rb[4];
    f32x4 acc[4][4];
#pragma unroll
    for (int i = 0; i < 4; ++i)
#pragma unroll
        for (int j = 0; j < 4; ++j) acc[i][j] = (f32x4){0.f, 0.f, 0.f, 0.f};
#pragma unroll
    for (int i = 0; i < 4; ++i) {
        ra[i] = *(const u32x4*)(Ag + (size_t)(32 * i) * lda);
        rb[i] = *(const u32x4*)(Bg + (size_t)(32 * i) * ldb);
    }
    const int nk = K >> 6;
    const int sw = (fr >> 1) & 7;
    for (int kt = 0; kt < nk; ++kt) {
        __syncthreads();
#pragma unroll
        for (int i = 0; i < 4; ++i) {
            *(u32x4*)(sA + swo + i * 32 * 64) = ra[i];
            *(u32x4*)(sB + swo + i * 32 * 64) = rb[i];
        }
        __syncthreads();
        if (kt + 1 < nk) {
#pragma unroll
            for (int i = 0; i < 4; ++i) {
                ra[i] = *(const u32x4*)(Ag + (size_t)(32 * i) * lda + (kt + 1) * 64);
                rb[i] = *(const u32x4*)(Bg + (size_t)(32 * i) * ldb + (kt + 1) * 64);
            }
        }
#pragma unroll
        for (int kk = 0; kk < 2; ++kk) {
            bf16x8 af[4], bfr[4];
            const int co = ((kk * 4 + fq) ^ sw) * 8;
#pragma unroll
            for (int mi = 0; mi < 4; ++mi) af[mi] = *(const bf16x8*)(sA + (wm * 64 + mi * 16 + fr) * 64 + co);
#pragma unroll
            for (int ni = 0; ni < 4; ++ni) bfr[ni] = *(const bf16x8*)(sB + (wn * 64 + ni * 16 + fr) * 64 + co);
#pragma unroll
            for (int mi = 0; mi < 4; ++mi)
#pragma unroll
                for (int ni = 0; ni < 4; ++ni)
                    acc[mi][ni] = __builtin_amdgcn_mfma_f32_16x16x32_bf16(bfr[ni], af[mi], acc[mi][ni], 0, 0, 0);
        }
    }
    epi(acc, pm * 128 + wm * 64, pn * 128 + wn * 64, fr, fq);
}

template <int NCOLS>
__device__ __forceinline__ void wave_store_rows(char* stg, const u32x2* pk, bf16_t* base0, int stride, int fr, int fq) {
#pragma unroll
    for (int ni = 0; ni < NCOLS / 16; ++ni) *(u32x2*)(stg + fr * 136 + (ni * 16 + 4 * fq) * 2) = pk[ni];
    const int lane = fq * 16 + fr;
    if (NCOLS == 64) {
#pragma unroll
        for (int hh = 0; hh < 2; ++hh) {
            const int r = (lane >> 3) + 8 * hh, c = (lane & 7) * 8;
            const u32x2 a = *(const u32x2*)(stg + r * 136 + c * 2), b = *(const u32x2*)(stg + r * 136 + c * 2 + 8);
            *(u32x4*)(base0 + (size_t)r * stride + c) = (u32x4){a.x, a.y, b.x, b.y};
        }
    } else {
        const int r = lane >> 2, c = (lane & 3) * 8;
        const u32x2 a = *(const u32x2*)(stg + r * 136 + c * 2), b = *(const u32x2*)(stg + r * 136 + c * 2 + 8);
        *(u32x4*)(base0 + (size_t)r * stride + c) = (u32x4){a.x, a.y, b.x, b.y};
    }
}
__device__ __forceinline__ u32x2 pk4(float a, float b, float c, float d) { u32x2 v; v.x = pack_bf16(a, b); v.y = pack_bf16(c, d); return v; }
__device__ __forceinline__ char* wave_stage(char* stage_base) { return stage_base + (fresh_tid() >> 6) * 4096; }
struct NoState {};
#define EPI_NOSTATE                                                                                             \
    typedef NoState State;                                                                                      \
    __device__ __forceinline__ State begin(int, int, int, int) const { return State{}; }
#define EPI_CALL_ALL                                                                                            \
    __device__ __forceinline__ void operator()(f32x4 (&acc)[4][4], int m0, int n0, int fr, int fq) const {      \
        const State st = begin(m0, n0, fr, fq);                                                                 \
        _Pragma("unroll") for (int mi = 0; mi < 4; ++mi) row(acc[mi], st, mi, m0 + mi * 16, n0, fr, fq);           \
    }

struct EpiEvenIn {
    bf16_t *Q, *Qc, *K, *Vt, *U, *VgT;
    const float *qg, *kg, *sg; char* stage_base;
    struct State { f32x4 gv[4]; };
    __device__ __forceinline__ State begin(int m0, int n0, int fr, int fq) const {
        State st;
        const float* g = n0 < 512 ? qg : (n0 < 640 ? kg : (n0 >= 1280 ? sg + (n0 - 1280) : nullptr));
#pragma unroll
        for (int ni = 0; ni < 4; ++ni) st.gv[ni] = g ? *(const f32x4*)(g + ni * 16 + 4 * fq) : (f32x4){0.f, 0.f, 0.f, 0.f};
        return st;
    }
    __device__ __forceinline__ void row(f32x4 (&a)[4], const State& st, int gi, int rowbase, int n0, int fr, int fq) const {
        asm volatile("" : "+v"(fr), "+v"(fq));
        const int row = rowbase + fr;
        int b, l; bool isctx; tokinfo(row, b, l, isctx);
        if (n0 < 640) {
            const bool isq = n0 < 512;
            const int head = isq ? (n0 >> 6) : ((n0 - 512) >> 6);
            float ss = 0.f;
#pragma unroll
            for (int ni = 0; ni < 4; ++ni)
#pragma unroll
                for (int j = 0; j < 4; ++j) ss += a[ni][j] * a[ni][j];
            ss += __shfl_xor(ss, 16); ss += __shfl_xor(ss, 32);
            const float r = rsqrtf(ss * (1.f / 64.f) + EPSF);
            bf16_t* dst;
            if (isq) dst = isctx ? Qc + ((size_t)((b * 8 + head) * 256 + l)) * 64 : Q + ((size_t)((b * 8 + head) * 2048 + l)) * 64;
            else dst = K + ((size_t)((b * 2 + head) * LK + (isctx ? l : 256 + l))) * 64;
            const float frow = (float)(l >> 6), fcol = (float)(l & 63);
            u32x2 pk[4];
#pragma unroll
            for (int ni = 0; ni < 4; ++ni) {
                const f32x4 gv = st.gv[ni];
                float v[4];
#pragma unroll
                for (int j = 0; j < 4; ++j) v[j] = a[ni][j] * r * gv[j];
                if (!isctx) {
#pragma unroll
                    for (int p = 0; p < 2; ++p) {
                        const int i = ni * 8 + 2 * fq + p;
                        const float inv = __builtin_amdgcn_exp2f(-(float)(i & 15) * (LOG2_THETA / 16.f));
                        const float ang = (i < 16 ? frow : fcol) * inv;
                        rot(v[2 * p], v[2 * p + 1], ang);
                    }
                }
                pk[ni] = pk4(v[0], v[1], v[2], v[3]);
            }
            wave_store_rows<64>(wave_stage(stage_base), pk, dst - fr * 64, 64, fr, fq);
        } else if (n0 < 768) {
            const int hk = (n0 - 640) >> 6;
            const int pos = isctx ? l : 256 + l;
            bf16_t* dst = Vt + ((size_t)(b * 2 + hk) * 64 + 4 * fq + (fr & 3)) * LK + (pos - (fr & 3));
#pragma unroll
            for (int ni = 0; ni < 4; ++ni) {
                float v[4] = {a[ni][0], a[ni][1], a[ni][2], a[ni][3]};
                quad_transpose(v, fr);
                store_bf16x4(dst + (size_t)(ni * 16) * LK, v[0], v[1], v[2], v[3]);
            }
        } else {
            const int zc = n0 - 768;
            float v[4][4];
#pragma unroll
            for (int ni = 0; ni < 4; ++ni)
#pragma unroll
                for (int j = 0; j < 4; ++j) v[ni][j] = gelu_tanh(a[ni][j]);
            if (zc < 512) {
                u32x2 pk[4];
#pragma unroll
                for (int ni = 0; ni < 4; ++ni) pk[ni] = pk4(v[ni][0], v[ni][1], v[ni][2], v[ni][3]);
                wave_store_rows<64>(wave_stage(stage_base), pk, U + (size_t)rowbase * 512 + zc, 512, fr, fq);
            } else {
                const int g = (zc - 512) >> 6;
                float ss = 0.f;
#pragma unroll
                for (int ni = 0; ni < 4; ++ni)
#pragma unroll
                    for (int j = 0; j < 4; ++j) ss += v[ni][j] * v[ni][j];
                ss += __shfl_xor(ss, 16); ss += __shfl_xor(ss, 32);
                const float r = rsqrtf(ss * (1.f / 64.f) + EPSF);
                bf16_t* dst = VgT + ((size_t)(g * 288 + (row >> 7)) * 64 + 4 * fq + (fr & 3)) * 128 + ((row & 127) - (fr & 3));
#pragma unroll
                for (int ni = 0; ni < 4; ++ni) {
                    const f32x4 gv = st.gv[ni];
                    float t[4] = {v[ni][0] * r * gv[0], v[ni][1] * r * gv[1], v[ni][2] * r * gv[2], v[ni][3] * r * gv[3]};
                    quad_transpose(t, fr);
                    store_bf16x4(dst + (ni * 16) * 128, t[0], t[1], t[2], t[3]);
                }
            }
        }
    }
    EPI_CALL_ALL
};

__device__ __forceinline__ float row16_sum(float x) {
    x += __int_as_float(__builtin_amdgcn_update_dpp(0, __float_as_int(x), 0xB1, 0xf, 0xf, false));
    x += __int_as_float(__builtin_amdgcn_update_dpp(0, __float_as_int(x), 0x4E, 0xf, 0xf, false));
    x += __int_as_float(__builtin_amdgcn_update_dpp(0, __float_as_int(x), 0x141, 0xf, 0xf, false));
    x += __int_as_float(__builtin_amdgcn_update_dpp(0, __float_as_int(x), 0x140, 0xf, 0xf, false));
    return x;
}
__device__ __forceinline__ void stage_rows(f32x4 (&a)[4], f32x4 (&v)[4], char* stg, int lane) {
    const int fr = lane & 15, fq = lane >> 4;
#pragma unroll
    for (int ni = 0; ni < 4; ++ni) *(f32x4*)(stg + fr * 256 + (((4 * ni + fq) ^ fr) * 16)) = a[ni];
#pragma unroll
    for (int k = 0; k < 4; ++k) { const int r = fq + 4 * k; v[k] = *(const f32x4*)(stg + r * 256 + ((fr ^ r) * 16)); }
}

template <bool NEXT, int DUPM = 0>
struct EpiResid {
    const float *xin_lat, *xin_ctx; float *xout_lat, *xout_ctx; const float* gate;
    bf16_t* hA; const float* ng; const float* scp; float* ssq;
    struct State { f32x4 g[4]; f32x4 gs[4]; };
    __device__ __forceinline__ State begin(int m0, int n0, int fr, int fq) const {
        State st;
        const int mrow = m0 < NLAT ? (m0 >> 11) : 16;
#pragma unroll
        for (int ni = 0; ni < 4; ++ni) {
            st.g[ni] = *(const f32x4*)(gate + (size_t)mrow * 6144 + n0 + 4 * fq + ni * 16);
            if (DUPM == 2) st.g[ni] *= 0.f;
            if (NEXT) {
                const f32x4 n4 = *(const f32x4*)(ng + n0 + 4 * fq + ni * 16);
                const f32x4 s4 = *(const f32x4*)(scp + (size_t)mrow * 6144 + n0 + 4 * fq + ni * 16);
                st.gs[ni] = n4 * (s4 + 1.f);
            }
        }
        return st;
    }
    static constexpr bool STAGED = true;
    struct SState { f32x4 g, gs; };
    __device__ __forceinline__ SState sbegin(int m0, int n0, int lane, int) const {
        SState st;
        const int mrow = m0 < NLAT ? (m0 >> 11) : 16, c = n0 + 4 * (lane & 15);
        st.g = *(const f32x4*)(gate + (size_t)mrow * 6144 + c);
        if (DUPM == 2) st.g *= 0.f;
        if (NEXT) st.gs = *(const f32x4*)(ng + c) * (*(const f32x4*)(scp + (size_t)mrow * 6144 + c) + 1.f);
        return st;
    }
    struct SLoad { f32x4 x[4]; };
    __device__ __forceinline__ SLoad sload(int rowbase, int n0, int lane) const {
        SLoad L;
        const int c = n0 + 4 * (lane & 15);
        const bool isctx = rowbase >= NLAT;
        const float* xi0 = (isctx ? xin_ctx + (size_t)(rowbase - NLAT) * 1024 : xin_lat + (size_t)rowbase * 1024) + c;
#pragma unroll
        for (int k = 0; k < 4; ++k) L.x[k] = __builtin_nontemporal_load((const f32x4*)(xi0 + (size_t)((lane >> 4) + 4 * k) * 1024));
        return L;
    }
    __device__ __forceinline__ void srow(f32x4 (&a)[4], const SState& st, const SLoad& ld, int gi, int rowbase, int n0, int lane, char* stg) const {
        f32x4 v[4];
        stage_rows(a, v, stg, lane);
        const int c = n0 + 4 * (lane & 15);
        const bool isctx = rowbase >= NLAT;
        float* xo0 = (isctx ? xout_ctx + (size_t)(rowbase - NLAT) * 1024 : xout_lat + (size_t)rowbase * 1024) + c;
        const f32x4 (&x4)[4] = ld.x;
#pragma unroll
        for (int k = 0; k < 4; ++k) {
            const int r = (lane >> 4) + 4 * k;
            const f32x4 xn = x4[k] + st.g * v[k];
            store_f32x4_nt(xo0 + (size_t)r * 1024, xn);
            if (NEXT) {
                const f32x4 hv = xn * st.gs;
                store_bf16x4(hA + (size_t)(rowbase + r) * 1024 + c, hv[0], hv[1], hv[2], hv[3]);
                const float ss = row16_sum(xn[0] * xn[0] + xn[1] * xn[1] + xn[2] * xn[2] + xn[3] * xn[3]);
                if ((lane & 15) == 0 && DUPM == 0) atomicAdd(ssq + rowbase + r, ss);
            }
        }
    }
    __device__ __forceinline__ void row(f32x4 (&a)[4], const State& st, int gi, int rowbase, int n0, int fr, int fq) const {
        const int row = rowbase + fr;
        const bool isctx = row >= NLAT;
        const float* xi = (isctx ? xin_ctx + (size_t)(row - NLAT) * 1024 : xin_lat + (size_t)row * 1024) + n0 + 4 * fq;
        float* xo = (isctx ? xout_ctx + (size_t)(row - NLAT) * 1024 : xout_lat + (size_t)row * 1024) + n0 + 4 * fq;
        float ss = 0.f;
#pragma unroll
        for (int ni = 0; ni < 4; ++ni) {
            const f32x4 x4 = *(const f32x4*)(xi + ni * 16);
            const f32x4 xn = x4 + st.g[ni] * a[ni];
            *(f32x4*)(xo + ni * 16) = xn;
            if (NEXT) {
                ss += xn[0] * xn[0] + xn[1] * xn[1] + xn[2] * xn[2] + xn[3] * xn[3];
                const f32x4 hv = xn * st.gs[ni];
                store_bf16x4(hA + (size_t)row * 1024 + n0 + 4 * fq + ni * 16, hv[0], hv[1], hv[2], hv[3]);
            }
        }
        if (NEXT) {
            ss += __shfl_xor(ss, 16); ss += __shfl_xor(ss, 32);
            if (fq == 0 && DUPM == 0) atomicAdd(ssq + row, ss);
        }
    }
    EPI_CALL_ALL
};

struct EpiPartial {
    float* part; int rows;
    static constexpr bool STAGED = true;
    struct SState { int ks; };
    __device__ __forceinline__ SState sbegin(int, int, int, int ks) const { return SState{ks}; }
    struct SLoad {};
    __device__ __forceinline__ SLoad sload(int, int, int) const { return SLoad{}; }
    __device__ __forceinline__ void srow(f32x4 (&a)[4], const SState& st, const SLoad&, int gi, int rowbase, int n0, int lane, char* stg) const {
        f32x4 v[4];
        stage_rows(a, v, stg, lane);
        float* dst = part + ((size_t)st.ks * rows + rowbase) * 1024 + n0 + 4 * (lane & 15);
#pragma unroll
        for (int k = 0; k < 4; ++k) *(f32x4*)(dst + (size_t)((lane >> 4) + 4 * k) * 1024) = v[k];
    }
};
__device__ __forceinline__ void combine_item(const float* __restrict__ part, float* __restrict__ xctx, const float* __restrict__ gate, const float* __restrict__ ng,
                                             const float* __restrict__ scp, bf16_t* __restrict__ hA, float* __restrict__ ssq, int item, bool dup) {
    const int lane = VTID & 63, w = VTID >> 6;
    const int r = item * 4 + w;
    float ss = 0.f;
#pragma unroll
    for (int i = 0; i < 4; ++i) {
        const int col = i * 256 + lane * 4;
        const size_t e = (size_t)r * 1024 + col;
        f32x4 sum = *(const f32x4*)(part + e);
        sum += *(const f32x4*)(part + (size_t)NCTX * 1024 + e);
        sum += *(const f32x4*)(part + (size_t)2 * NCTX * 1024 + e);
        sum += *(const f32x4*)(part + (size_t)3 * NCTX * 1024 + e);
        f32x4 g4 = *(const f32x4*)(gate + col);
        if (dup) g4 *= 0.f;
        const f32x4 xn = *(const f32x4*)(xctx + e) + g4 * sum;
        *(f32x4*)(xctx + e) = xn;
        const f32x4 hv = xn * (*(const f32x4*)(ng + col) * (*(const f32x4*)(scp + col) + 1.f));
        store_bf16x4(hA + (size_t)(NLAT + r) * 1024 + col, hv[0], hv[1], hv[2], hv[3]);
        ss += xn[0] * xn[0] + xn[1] * xn[1] + xn[2] * xn[2] + xn[3] * xn[3];
    }
#pragma unroll
    for (int o = 32; o >= 1; o >>= 1) ss += __shfl_xor(ss, o);
    if (lane == 0 && !dup) ssq[NLAT + r] = ss;
}

struct EpiSqRelu {
    bf16_t* hid; const float* ssq; const float* bias; int Mrows;
    static constexpr bool STAGED = true;
    struct SState { f32x4 b; float r0, r1; };
    __device__ __forceinline__ SState sbegin(int m0, int n0, int lane, int) const {
        SState st;
        const int mrow = m0 < NLAT ? (m0 >> 11) : 16;
        st.b = *(const f32x4*)(bias + (size_t)mrow * 4096 + n0 + 4 * (lane & 15));
        st.r0 = rsqrtf(ssq[m0 + lane] * (1.f / 1024.f) + EPSF);
        st.r1 = rsqrtf(ssq[m0 + 128 + lane] * (1.f / 1024.f) + EPSF);
        return st;
    }
    struct SLoad {};
    __device__ __forceinline__ SLoad sload(int, int, int) const { return SLoad{}; }
    __device__ __forceinline__ void srow(f32x4 (&a)[4], const SState& st, const SLoad&, int gi, int rowbase, int n0, int lane, char* stg) const {
        f32x4 v[4];
        stage_rows(a, v, stg, lane);
        const int c = n0 + 4 * (lane & 15);
        const float rsel = (gi >> 2) ? st.r1 : st.r0;
#pragma unroll
        for (int k = 0; k < 4; ++k) {
            const int r = (lane >> 4) + 4 * k;
            const float rs = __int_as_float(__builtin_amdgcn_ds_bpermute(4 * ((gi & 3) * 16 + r), __float_as_int(rsel)));
            float o[4];
#pragma unroll
            for (int j = 0; j < 4; ++j) { const float t = fmaxf(v[k][j] * rs + st.b[j], 0.f); o[j] = t * t; }
            store_bf16x4_nt(hid + ((size_t)(n0 >> 6) * Mrows + rowbase + r) * 64 + 4 * (lane & 15), o[0], o[1], o[2], o[3]);
        }
    }
    struct State { f32x4 b[4]; };
    __device__ __forceinline__ State begin(int m0, int n0, int fr, int fq) const {
        State st;
        const int mrow = m0 < NLAT ? (m0 >> 11) : 16;
#pragma unroll
        for (int ni = 0; ni < 4; ++ni) st.b[ni] = *(const f32x4*)(bias + (size_t)mrow * 4096 + n0 + 4 * fq + ni * 16);
        return st;
    }
    __device__ __forceinline__ void row(f32x4 (&a)[4], const State& st, int gi, int rowbase, int n0, int fr, int fq) const {
        const int row = rowbase + fr;
        const float r = rsqrtf(ssq[row] * (1.f / 1024.f) + EPSF);
#pragma unroll
        for (int ni = 0; ni < 4; ++ni) {
            const f32x4 b4 = st.b[ni];
            float v[4];
#pragma unroll
            for (int j = 0; j < 4; ++j) { float t = fmaxf(a[ni][j] * r + b4[j], 0.f); v[j] = t * t; }
            store_bf16x4(hid + ((size_t)(n0 >> 6) * Mrows + row) * 64 + ni * 16 + 4 * fq, v[0], v[1], v[2], v[3]);
        }
    }
    EPI_CALL_ALL
};

template <int DUPM = 0>
struct EpiOddIn {
    bf16_t *CQ, *CKV, *K2, *GLU; float* ssq;
    const float* ssq_in; const float* bias;
    char* stage_base;
    struct State { f32x4 b[4]; float r[8]; };
    __device__ __forceinline__ State begin(int m0, int n0, int fr, int fq) const {
        State st;
        const int mrow = m0 < NLAT ? (m0 >> 11) : 16;
#pragma unroll
        for (int ni = 0; ni < 4; ++ni) st.b[ni] = *(const f32x4*)(bias + (size_t)mrow * 1536 + n0 + 4 * fq + ni * 16);
#pragma unroll
        for (int gi = 0; gi < 8; ++gi) st.r[gi] = ssq_in[m0 + (gi >> 2) * 128 + (gi & 3) * 16 + fr];
#pragma unroll
        for (int gi = 0; gi < 8; ++gi) st.r[gi] = rsqrtf(st.r[gi] * (1.f / 1024.f) + EPSF);
        return st;
    }
    __device__ __forceinline__ void row(f32x4 (&a)[4], const State& st, int gi, int rowbase, int n0, int fr, int fq) const {
        const int row = rowbase + fr;
        {
            const float r_in = st.r[gi];
#pragma unroll
            for (int ni = 0; ni < 4; ++ni) a[ni] = a[ni] * r_in + st.b[ni];
        }
        if (n0 < 384) {
            const bool isq = n0 < 256;
            float ss = 0.f;
            u32x2 pk[4];
#pragma unroll
            for (int ni = 0; ni < 4; ++ni) {
#pragma unroll
                for (int j = 0; j < 4; ++j) ss += a[ni][j] * a[ni][j];
                pk[ni] = pk4(a[ni][0], a[ni][1], a[ni][2], a[ni][3]);
            }
            wave_store_rows<64>(wave_stage(stage_base), pk, CQ + (size_t)rowbase * 384 + n0, 384, fr, fq);
            ss += __shfl_xor(ss, 16); ss += __shfl_xor(ss, 32);
            if (fq == 0 && DUPM == 0) atomicAdd(ssq + (isq ? 0 : NTOK) + row, ss);
        } else if (n0 < 448) {
            int b, l; bool isctx; tokinfo(row, b, l, isctx);
            const int pos = isctx ? l : 256 + l;
            const float frow = (float)(l >> 6), fcol = (float)(l & 63);
#pragma unroll
            for (int ni = 0; ni < 2; ++ni) {
                float v[4];
#pragma unroll
                for (int j = 0; j < 4; ++j) v[j] = a[ni][j];
                if (!isctx) {
#pragma unroll
                    for (int p = 0; p < 2; ++p) {
                        const int i = ni * 8 + 2 * fq + p;
                        const float inv = __builtin_amdgcn_exp2f(-(float)(i & 7) * (LOG2_THETA / 8.f));
                        rot(v[2 * p], v[2 * p + 1], (i < 8 ? frow : fcol) * inv);
                    }
                }
#pragma unroll
                for (int h = 0; h < 8; ++h)
                    store_bf16x4(K2 + ((size_t)((b * 8 + h) * LK + pos)) * 96 + 64 + ni * 16 + 4 * fq, v[0], v[1], v[2], v[3]);
            }
        } else if (n0 >= 512) {
            const int wt = (n0 - 512) >> 6;
            u32x2 pk[2];
#pragma unroll
            for (int ni = 0; ni < 2; ++ni) {
                float v[4];
#pragma unroll
                for (int j = 0; j < 4; ++j) v[j] = a[ni][j] * sigmoidf_(a[ni + 2][j]);
                pk[ni] = pk4(v[0], v[1], v[2], v[3]);
            }
            wave_store_rows<32>(wave_stage(stage_base), pk, GLU + (size_t)rowbase * 512 + wt * 32, 512, fr, fq);
        }
    }
    EPI_CALL_ALL
};

struct EpiUp {
    bf16_t *Q2, *K2, *V2t; const float *ssq_q, *ssq_kv; char* stage_base;
    struct State { float r[8]; };
    __device__ __forceinline__ State begin(int m0, int n0, int fr, int fq) const {
        State st;
        const bool isq = n0 < 768;
        const float* sp = isq ? ssq_q : ssq_kv;
        const float sc = isq ? (1.f / 256.f) : (1.f / 128.f);
#pragma unroll
        for (int gi = 0; gi < 8; ++gi) st.r[gi] = sp[m0 + (gi >> 2) * 128 + (gi & 3) * 16 + fr];
#pragma unroll
        for (int gi = 0; gi < 8; ++gi) st.r[gi] = rsqrtf(st.r[gi] * sc + EPSF);
        return st;
    }
    __device__ __forceinline__ void row(f32x4 (&a)[4], const State& st, int gi, int rowbase, int n0, int fr, int fq) const {
        asm volatile("" : "+v"(fr), "+v"(fq));
        const int row = rowbase + fr;
        const float r = st.r[gi];
        if (n0 < 768) {
            if (rowbase >= NLAT) return;
            const int b = row >> 11, l = row & 2047;
            const float frow = (float)(l >> 6), fcol = (float)(l & 63);
#pragma unroll
            for (int ni = 0; ni < 4; ++ni) {
                const int col = n0 + ni * 16 + 4 * fq;
                const int h = col / 96, d = col - h * 96;
                float v[4];
#pragma unroll
                for (int j = 0; j < 4; ++j) v[j] = a[ni][j] * r;
                if (d >= 64) {
#pragma unroll
                    for (int p = 0; p < 2; ++p) {
                        const int i = ((d - 64) >> 1) + p;
                        const float inv = __builtin_amdgcn_exp2f(-(float)(i & 7) * (LOG2_THETA / 8.f));
                        rot(v[2 * p], v[2 * p + 1], (i < 8 ? frow : fcol) * inv);
                    }
                }
                store_bf16x4(Q2 + ((size_t)((b * 8 + h) * 2048 + l)) * 96 + d, v[0], v[1], v[2], v[3]);
            }
        } else {
            const int nk = n0 - 768;
            const int h = nk >> 7;
            const bool isv = (nk & 64) != 0;
            int b, l; bool isctx; tokinfo(row, b, l, isctx);
            const int pos = isctx ? l : 256 + l;
            if (!isv) {
                bf16_t* dst = K2 + ((size_t)((b * 8 + h) * LK + pos)) * 96;
                u32x2 pk[4];
#pragma unroll
                for (int ni = 0; ni < 4; ++ni) pk[ni] = pk4(a[ni][0] * r, a[ni][1] * r, a[ni][2] * r, a[ni][3] * r);
                wave_store_rows<64>(wave_stage(stage_base), pk, dst - fr * 96, 96, fr, fq);
            } else {
                bf16_t* dst = V2t + ((size_t)(b * 8 + h) * 64 + 4 * fq + (fr & 3)) * LK + (pos - (fr & 3));
#pragma unroll
                for (int ni = 0; ni < 4; ++ni) {
                    float v[4] = {a[ni][0] * r, a[ni][1] * r, a[ni][2] * r, a[ni][3] * r};
                    quad_transpose(v, fr);
                    store_bf16x4(dst + (size_t)(ni * 16) * LK, v[0], v[1], v[2], v[3]);
                }
            }
        }
    }
};

struct EpiGate {
    const bf16_t* U; bf16_t* Omix; const float* bias; int g;
    EPI_NOSTATE
    __device__ __forceinline__ void row(f32x4 (&a)[4], const State& st, int gi, int rowbase, int n0, int fr, int fq) const {
        const int pp = rowbase + fr;
        const float bs = bias[pp];
#pragma unroll
        for (int ni = 0; ni < 4; ++ni) {
            const int col = n0 + ni * 16 + 4 * fq;
            const int chunk = col >> 6, c = col & 63;
            const size_t tok = (size_t)chunk * 128 + pp;
            const u32x2 u = *(const u32x2*)(U + tok * 512 + g * 64 + c);
            store_bf16x4(Omix + tok * 1024 + 512 + g * 64 + c, (a[ni][0] + bs) * bf_lo(u.x), (a[ni][1] + bs) * bf_hi(u.x),
                         (a[ni][2] + bs) * bf_lo(u.y), (a[ni][3] + bs) * bf_hi(u.y));
        }
    }
    EPI_CALL_ALL
};

__device__ __forceinline__ float rows_max(float x) {
    unsigned u = __float_as_uint(x);
    u32x2 r = __builtin_amdgcn_permlane16_swap(u, u, false, false);
    const float m = fmaxf(__uint_as_float(r.x), __uint_as_float(r.y));
    u = __float_as_uint(m);
    r = __builtin_amdgcn_permlane32_swap(u, u, false, false);
    return fmaxf(__uint_as_float(r.x), __uint_as_float(r.y));
}
__device__ __forceinline__ float rows_sum(float x) {
    unsigned u = __float_as_uint(x);
    u32x2 r = __builtin_amdgcn_permlane16_swap(u, u, false, false);
    const float m = __uint_as_float(r.x) + __uint_as_float(r.y);
    u = __float_as_uint(m);
    r = __builtin_amdgcn_permlane32_swap(u, u, false, false);
    return __uint_as_float(r.x) + __uint_as_float(r.y);
}

template <int DQK>
__device__ __forceinline__ void attn_item(const bf16_t* __restrict__ Qb, const bf16_t* __restrict__ Kb, const bf16_t* __restrict__ Vtb,
                                          bf16_t* __restrict__ Omix, int item, int Lq, int nkeys, int hk_div, int rowbase, float cexp, char* smem) {
    constexpr int KSTR = (DQK == 64) ? 64 : 128;
    constexpr int NDC = DQK / 32;
    constexpr int KCH = DQK / 8;
    constexpr int NC = 64 * KCH;
    constexpr int NKL = (NC + 511) / 512;
    constexpr int BUFE = 64 * KSTR + 64 * 72;
    bf16_t* const sbase = (bf16_t*)smem;
    const int tid = (int)fresh_tid(), lane = tid & 63, w = tid >> 6, fr = lane & 15, fq = lane >> 4;
    const int nqt = Lq >> 8;
    const int qt = item % nqt, h = (item / nqt) & 7, b = item / (nqt * 8);
    const int nkvh = 8 / hk_div, hk = h / hk_div;
    const bf16_t* Qp = Qb + ((size_t)((b * 8 + h) * Lq + qt * 256 + w * 32)) * DQK;
    const bf16_t* Kp = Kb + (size_t)(b * nkvh + hk) * LK * DQK;
    const bf16_t* Vp = Vtb + (size_t)(b * nkvh + hk) * 64 * LK;

    bf16x8 qf[2][NDC];
#pragma unroll
    for (int qb = 0; qb < 2; ++qb)
#pragma unroll
        for (int dc = 0; dc < NDC; ++dc) {
            const u32x4 q4 = *(const u32x4*)(Qp + (qb * 16 + fr) * DQK + dc * 32 + fq * 8);
            u32x4 r4;
#pragma unroll
            for (int e = 0; e < 4; ++e) r4[e] = pack_bf16(bf_lo(q4[e]) * cexp, bf_hi(q4[e]) * cexp);
            qf[qb][dc] = __builtin_bit_cast(bf16x8, r4);
        }

    int koff_g[NKL], koff_s[NKL];
#pragma unroll
    for (int i = 0; i < NKL; ++i) {
        const int c = (tid + 512 * i) < NC ? tid + 512 * i : tid, row = c / KCH, ch = c % KCH;
        koff_g[i] = row * DQK + ch * 8;
        koff_s[i] = (DQK == 64) ? row * 64 + ((ch ^ ((row >> 1) & 7)) * 8) : row * 128 + ((ch ^ (row & 15)) * 8);
    }
    u32x4 rk[NKL], rv[2];
#pragma unroll
    for (int i = 0; i < NKL; ++i) rk[i] = *(const u32x4*)(Kp + koff_g[i]);
#pragma unroll
    for (int i = 0; i < 1; ++i) { const int c = tid; rv[i] = *(const u32x4*)(Vp + (size_t)(c >> 3) * LK + (c & 7) * 8); }

    f32x4 o[2][5];
    float m[2];
#pragma unroll
    for (int qb = 0; qb < 2; ++qb) {
        m[qb] = -1e30f;
#pragma unroll
        for (int d = 0; d < 5; ++d) o[qb][d] = (f32x4){0.f, 0.f, 0.f, 0.f};
    }
    const u32x4 ones_u = {0x3F803F80u, 0x3F803F80u, 0x3F803F80u, 0x3F803F80u};
    const bf16x8 ones = __builtin_bit_cast(bf16x8, ones_u);
    const int nt = nkeys >> 6;
    {
#pragma unroll
        for (int i = 0; i < NKL; ++i) *(u32x4*)(sbase + koff_s[i]) = rk[i];
#pragma unroll
        for (int i = 0; i < 1; ++i) { const int c = tid; *(u32x4*)(sbase + 64 * KSTR + (c >> 3) * 72 + (c & 7) * 8) = rv[i]; }
#pragma unroll
        for (int i = 0; i < NKL; ++i) rk[i] = *(const u32x4*)(Kp + (size_t)64 * DQK + koff_g[i]);
#pragma unroll
        for (int i = 0; i < 1; ++i) { const int c = tid; rv[i] = *(const u32x4*)(Vp + (size_t)(c >> 3) * LK + 64 + (c & 7) * 8); }
    }
    __syncthreads();
    for (int kt = 0; kt < nt; ++kt) {
        const bf16_t* sK = sbase + (kt & 1) * BUFE;
        const bf16_t* sV = sK + 64 * KSTR;
        f32x4 s[2][4];
        __builtin_amdgcn_s_setprio(1);
#pragma unroll
        for (int kb = 0; kb < 4; ++kb) {
#pragma unroll
            for (int qb = 0; qb < 2; ++qb) s[qb][kb] = (f32x4){0.f, 0.f, 0.f, 0.f};
#pragma unroll
            for (int dc = 0; dc < NDC; ++dc) {
                const int row = kb * 16 + fr, ch = dc * 4 + fq;
                const int off = (DQK == 64) ? row * 64 + ((ch ^ ((row >> 1) & 7)) * 8) : row * 128 + ((ch ^ (row & 15)) * 8);
                const bf16x8 kf = *(const bf16x8*)(sK + off);
#pragma unroll
                for (int qb = 0; qb < 2; ++qb) s[qb][kb] = __builtin_amdgcn_mfma_f32_16x16x32_bf16(kf, qf[qb][dc], s[qb][kb], 0, 0, 0);
            }
        }
        __builtin_amdgcn_s_setprio(0);
        if (kt + 1 < nt) {
            bf16_t* nK = sbase + ((kt + 1) & 1) * BUFE;
#pragma unroll
            for (int i = 0; i < NKL; ++i) *(u32x4*)(nK + koff_s[i]) = rk[i];
#pragma unroll
            for (int i = 0; i < 1; ++i) { const int c = tid; *(u32x4*)(nK + 64 * KSTR + (c >> 3) * 72 + (c & 7) * 8) = rv[i]; }
            if (kt + 2 < nt) {
#pragma unroll
                for (int i = 0; i < NKL; ++i) rk[i] = *(const u32x4*)(Kp + (size_t)(kt + 2) * 64 * DQK + koff_g[i]);
#pragma unroll
                for (int i = 0; i < 1; ++i) { const int c = tid; rv[i] = *(const u32x4*)(Vp + (size_t)(c >> 3) * LK + (kt + 2) * 64 + (c & 7) * 8); }
            }
        }
        bf16x8 pb[2][2];
#pragma unroll
        for (int qb = 0; qb < 2; ++qb) {
            float mx = s[qb][0][0];
#pragma unroll
            for (int kb = 0; kb < 4; ++kb)
#pragma unroll
                for (int j = 0; j < 4; ++j) mx = fmaxf(mx, s[qb][kb][j]);
            mx = rows_max(mx);
            const float mnew = fmaxf(m[qb], mx);
            const float alpha = __builtin_amdgcn_exp2f(m[qb] - mnew);
            m[qb] = mnew;
            unsigned pk[8];
#pragma unroll
            for (int kb = 0; kb < 4; ++kb) {
                const f32x4 d = s[qb][kb] - mnew;
                const float p0 = __builtin_amdgcn_exp2f(d[0]), p1 = __builtin_amdgcn_exp2f(d[1]);
                const float p2 = __builtin_amdgcn_exp2f(d[2]), p3 = __builtin_amdgcn_exp2f(d[3]);
                pk[kb * 2] = pack_bf16(p0, p1); pk[kb * 2 + 1] = pack_bf16(p2, p3);
            }
            u32x4 t0 = {pk[0], pk[1], pk[2], pk[3]}, t1 = {pk[4], pk[5], pk[6], pk[7]};
            pb[qb][0] = __builtin_bit_cast(bf16x8, t0);
            pb[qb][1] = __builtin_bit_cast(bf16x8, t1);
            if (__builtin_amdgcn_ballot_w64(alpha != 1.f) != 0ull) {
#pragma unroll
                for (int d = 0; d < 5; ++d) o[qb][d] *= alpha;
            }
        }
        __builtin_amdgcn_s_setprio(1);
#pragma unroll
        for (int dvb = 0; dvb < 4; ++dvb)
#pragma unroll
            for (int ks = 0; ks < 2; ++ks) {
                const bf16_t* vp = sV + (dvb * 16 + fr) * 72 + ks * 32 + fq * 4;
                const u32x2 v0 = *(const u32x2*)vp, v1 = *(const u32x2*)(vp + 16);
                    u32x4 t = {v0.x, v0.y, v1.x, v1.y};
                const bf16x8 vf = __builtin_bit_cast(bf16x8, t);
#pragma unroll
                for (int qb = 0; qb < 2; ++qb) o[qb][dvb] = __builtin_amdgcn_mfma_f32_16x16x32_bf16(vf, pb[qb][ks], o[qb][dvb], 0, 0, 0);
            }
#pragma unroll
        for (int ks = 0; ks < 2; ++ks)
#pragma unroll
            for (int qb = 0; qb < 2; ++qb) o[qb][4] = __builtin_amdgcn_mfma_f32_16x16x32_bf16(ones, pb[qb][ks], o[qb][4], 0, 0, 0);
        __builtin_amdgcn_s_setprio(0);
        __syncthreads();
    }
#pragma unroll
    for (int qb = 0; qb < 2; ++qb) {
        const float inv = 1.f / o[qb][4][0];
        const size_t row = (size_t)rowbase + (size_t)b * Lq + qt * 256 + w * 32 + qb * 16 + fr;
#pragma unroll
        for (int dvb = 0; dvb < 4; ++dvb)
            store_bf16x4(Omix + row * 1024 + h * 64 + dvb * 16 + fq * 4, o[qb][dvb][0] * inv, o[qb][dvb][1] * inv, o[qb][dvb][2] * inv, o[qb][dvb][3] * inv);
    }
}

__device__ __forceinline__ void conv_item(const bf16_t* __restrict__ GLU, const float* __restrict__ cw, const float* __restrict__ cb,
                                          const float* __restrict__ lg, const float* __restrict__ lb, bf16_t* __restrict__ Omix, int item, char* smem) {
    float* ys = (float*)smem;
    const int tid = VTID, lane = tid & 63, w = tid >> 6;
    const int ch = 2 * tid;
    const int tok0 = item * 16, b = tok0 >> 11, l0 = tok0 & 2047;
    const bf16_t* gp = GLU + ((size_t)b * 2048) * 512 + ch;
    float w0[31], w1[31];
#pragma unroll
    for (int j = 0; j < 31; ++j) { const float2 t = *(const float2*)(cw + j * 512 + ch); w0[j] = t.x; w1[j] = t.y; }
    const float2 cbv = *(const float2*)(cb + ch);
    unsigned win[31];
#pragma unroll
    for (int j = 0; j < 31; ++j) {
        const int l = l0 - 15 + j;
        win[j] = (l >= 0 && l < 2048) ? *(const unsigned*)(gp + (size_t)l * 512) : 0u;
    }
    __syncthreads();
#pragma unroll 1
    for (int t = 0; t < 16; ++t) {
        float a0 = cbv.x, a1 = cbv.y;
#pragma unroll
        for (int j = 0; j < 31; ++j) { a0 += w0[j] * bf_lo(win[j]); a1 += w1[j] * bf_hi(win[j]); }
        *(float2*)(ys + t * 512 + ch) = make_float2(a0, a1);
        const int l = l0 + t + 16;
        const unsigned nx = (l < 2048) ? *(const unsigned*)(gp + (size_t)l * 512) : 0u;
#pragma unroll
        for (int j = 0; j < 30; ++j) win[j] = win[j + 1];
        win[30] = nx;
    }
    __syncthreads();
#pragma unroll 1
    for (int t = w; t < 16; t += 4) {
        const f32x4 v0 = *(const f32x4*)(ys + t * 512 + lane * 8), v1 = *(const f32x4*)(ys + t * 512 + lane * 8 + 4);
        float sm = (v0[0] + v0[1]) + (v0[2] + v0[3]) + (v1[0] + v1[1]) + (v1[2] + v1[3]);
#pragma unroll
        for (int o = 32; o >= 1; o >>= 1) sm += __shfl_xor(sm, o);
        const float mean = sm * (1.f / 512.f);
        float d[8];
        float sq = 0.f;
#pragma unroll
        for (int j = 0; j < 4; ++j) { d[j] = v0[j] - mean; d[4 + j] = v1[j] - mean; }
#pragma unroll
        for (int j = 0; j < 8; ++j) sq += d[j] * d[j];
#pragma unroll
        for (int o = 32; o >= 1; o >>= 1) sq += __shfl_xor(sq, o);
        const float r = rsqrtf(sq * (1.f / 512.f) + EPSF);
        const f32x4 g0 = *(const f32x4*)(lg + lane * 8), g1 = *(const f32x4*)(lg + lane * 8 + 4);
        const f32x4 b0 = *(const f32x4*)(lb + lane * 8), b1 = *(const f32x4*)(lb + lane * 8 + 4);
        float o_[8];
#pragma unroll
        for (int j = 0; j < 4; ++j) { o_[j] = d[j] * r * g0[j] + b0[j]; o_[4 + j] = d[4 + j] * r * g1[j] + b1[j]; }
#pragma unroll
        for (int j = 0; j < 8; ++j) o_[j] = o_[j] * sigmoidf_(o_[j]);
        u32x4 pk = {pack_bf16(o_[0], o_[1]), pack_bf16(o_[2], o_[3]), pack_bf16(o_[4], o_[5]), pack_bf16(o_[6], o_[7])};
        *(u32x4*)(Omix + (size_t)(tok0 + t) * 1024 + 512 + lane * 8) = pk;
    }
}

__device__ __forceinline__ void modulate_item(const float* __restrict__ xlat, const float* __restrict__ xctx, const float* __restrict__ ng,
                                              const float* __restrict__ modl, int sh_off, int sc_off, bf16_t* __restrict__ h, int item) {
    const int lane = VTID & 63, w = VTID >> 6;
    const int row = item * 4 + w;
    int b, l; bool isctx; tokinfo(row, b, l, isctx);
    const float* x = isctx ? xctx + (size_t)(row - NLAT) * 1024 : xlat + (size_t)row * 1024;
    const float* mp = modl + (size_t)(isctx ? 16 : b) * 6144;
    f32x4 v[4];
    float ss = 0.f;
#pragma unroll
    for (int i = 0; i < 4; ++i) {
        v[i] = *(const f32x4*)(x + i * 256 + lane * 4);
        ss += v[i][0] * v[i][0] + v[i][1] * v[i][1] + v[i][2] * v[i][2] + v[i][3] * v[i][3];
    }
#pragma unroll
    for (int o = 32; o >= 1; o >>= 1) ss += __shfl_xor(ss, o);
    const float r = rsqrtf(ss * (1.f / 1024.f) + EPSF);
#pragma unroll
    for (int i = 0; i < 4; ++i) {
        const int col = i * 256 + lane * 4;
        const f32x4 g4 = *(const f32x4*)(ng + col), sc = *(const f32x4*)(mp + sc_off + col), sh = *(const f32x4*)(mp + sh_off + col);
        float y[4];
#pragma unroll
        for (int j = 0; j < 4; ++j) y[j] = v[i][j] * r * g4[j] * (1.f + sc[j]) + sh[j];
        store_bf16x4(h + (size_t)row * 1024 + col, y[0], y[1], y[2], y[3]);
    }
}
__device__ __forceinline__ void finalnorm_item(float* x, float* xo, const float* __restrict__ g, int item) {
    const int lane = VTID & 63, w = VTID >> 6;
    float* xr = x + (size_t)(item * 4 + w) * 1024;
    f32x4 v[4];
    float ss = 0.f;
#pragma unroll
    for (int i = 0; i < 4; ++i) {
        v[i] = *(const f32x4*)(xr + i * 256 + lane * 4);
        ss += v[i][0] * v[i][0] + v[i][1] * v[i][1] + v[i][2] * v[i][2] + v[i][3] * v[i][3];
    }
#pragma unroll
    for (int o = 32; o >= 1; o >>= 1) ss += __shfl_xor(ss, o);
    const float r = rsqrtf(ss * (1.f / 1024.f) + EPSF);
#pragma unroll
    for (int i = 0; i < 4; ++i) {
        const f32x4 g4 = *(const f32x4*)(g + i * 256 + lane * 4);
        store_f32x4_nt(xo + (size_t)(item * 4 + w) * 1024 + i * 256 + lane * 4, v[i] * r * g4);
    }
}

__device__ __forceinline__ int odmap(int n) {
    if (n < 416) return n;
    if (n < 512) return -1;
    const int t = n - 512, wt = t >> 6, c = t & 63;
    return 416 + (c < 32 ? wt * 32 + c : 512 + wt * 32 + (c - 32));
}
__device__ __forceinline__ int perm256(int n) { const int p = n & 255; return (n & ~255) + 64 * ((p >> 5) & 3) + 32 * (p >> 7) + (p & 31); }
template <bool ODMAP, bool P256, bool TILED = false>
__device__ __forceinline__ void tconv_tile(const float* __restrict__ src, int ldsrc, bf16_t* __restrict__ dst, int K, const float* __restrict__ rs,
                                           int tile, char* smem, int nrows_t = 0) {
    float* t = (float*)smem;
    const int nkt = K >> 6;
    const int kt = tile % nkt, ntile = tile / nkt;
    const int k0 = kt * 64, n0 = ntile * 64;
    const int tid = VTID;
    __syncthreads();
    {
        const int c4 = (tid & 15) * 4, kr = tid >> 4;
        const int ln = P256 ? perm256(n0 + c4) : n0 + c4;
        const int sn = ODMAP ? odmap(ln) : ln;
#pragma unroll
        for (int i = 0; i < 4; ++i) {
            const int k = i * 16 + kr;
            f32x4 v = sn >= 0 ? *(const f32x4*)(src + (size_t)(k0 + k) * ldsrc + sn) : (f32x4){0.f, 0.f, 0.f, 0.f};
            if (rs) v *= rs[k0 + k];
            t[k * 65 + c4 + 0] = v[0]; t[k * 65 + c4 + 1] = v[1]; t[k * 65 + c4 + 2] = v[2]; t[k * 65 + c4 + 3] = v[3];
        }
    }
    __syncthreads();
#pragma unroll
    for (int j = 0; j < 2; ++j) {
        const int n = (tid >> 3) + 32 * j, kc = (tid & 7) * 8;
        u32x4 o;
        o.x = pack_bf16(t[(kc + 0) * 65 + n], t[(kc + 1) * 65 + n]);
        o.y = pack_bf16(t[(kc + 2) * 65 + n], t[(kc + 3) * 65 + n]);
        o.z = pack_bf16(t[(kc + 4) * 65 + n], t[(kc + 5) * 65 + n]);
        o.w = pack_bf16(t[(kc + 6) * 65 + n], t[(kc + 7) * 65 + n]);
        if (TILED) *(u32x4*)(dst + ((size_t)kt * nrows_t + n0 + n) * 64 + kc) = o;
        else *(u32x4*)(dst + (size_t)(n0 + n) * K + k0 + kc) = o;
    }
}
__device__ __forceinline__ void upw_tile(const Params& p, bf16_t* __restrict__ dst, int tile, char* smem) {
    float* t = (float*)smem;
    const int kt = tile % 6, ntile = tile / 6;
    const int k0 = kt * 64, n0 = ntile * 64;
    const int tid = VTID;
    const bool isq = n0 < 768;
    const bool kvalid = isq ? (k0 < 256) : (k0 >= 256);
    const float* src = isq ? p.od_w_uq : p.od_w_ukv;
    const int ld = isq ? 768 : 1024;
    const int ks0 = isq ? k0 : k0 - 256;
    const float* rs = isq ? p.od_q_norm_g : p.od_kv_norm_g;
    __syncthreads();
    {
        const int n = tid & 63;
        const int ln = perm256(n0 + n) - (isq ? 0 : 768);
#pragma unroll
        for (int i = 0; i < 16; ++i) {
            const int k = i * 4 + (tid >> 6);
            t[k * 65 + n] = kvalid ? src[(size_t)(ks0 + k) * ld + ln] * rs[ks0 + k] : 0.f;
        }
    }
    __syncthreads();
#pragma unroll
    for (int j = 0; j < 2; ++j) {
        const int n = (tid >> 3) + 32 * j, kc = (tid & 7) * 8;
        u32x4 o;
        o.x = pack_bf16(t[(kc + 0) * 65 + n], t[(kc + 1) * 65 + n]);
        o.y = pack_bf16(t[(kc + 2) * 65 + n], t[(kc + 3) * 65 + n]);
        o.z = pack_bf16(t[(kc + 4) * 65 + n], t[(kc + 5) * 65 + n]);
        o.w = pack_bf16(t[(kc + 6) * 65 + n], t[(kc + 7) * 65 + n]);
        *(u32x4*)(dst + (size_t)(n0 + n) * 384 + k0 + kc) = o;
    }
}
__device__ __forceinline__ void ada_item(const Params& p, float* __restrict__ mod, int item, char* smem) {
    float* s = (float*)smem;
    const int tid = VTID;
    const int layer = item / 96, n0 = (item % 96) * 64;
    const int col = tid & 63, ks = tid >> 6;
    float acc[17];
#pragma unroll
    for (int r = 0; r < 17; ++r) acc[r] = 0.f;
    for (int half = 0; half < 2; ++half) {
        __syncthreads();
        for (int idx = tid; idx < 17 * 512; idx += 256) {
            const int r = idx >> 9, k = (idx & 511) + half * 512;
            const float v = r < 16 ? p.c[r * 1024 + k] : p.c_ctx[k];
            s[idx] = v * sigmoidf_(v);
        }
        __syncthreads();
        const float* wp = p.ada_w + ((size_t)layer * 1024 + half * 512 + ks * 128) * 6144 + n0 + col;
        for (int k0 = 0; k0 < 128; k0 += 16) {
            float wv[16];
#pragma unroll
            for (int kk = 0; kk < 16; ++kk) wv[kk] = wp[(size_t)(k0 + kk) * 6144];
#pragma unroll
            for (int kk = 0; kk < 16; ++kk)
#pragma unroll
                for (int r = 0; r < 17; ++r) acc[r] += s[r * 512 + ks * 128 + k0 + kk] * wv[kk];
        }
    }
    __syncthreads();
#pragma unroll
    for (int r = 0; r < 17; ++r) s[(ks * 17 + r) * 64 + col] = acc[r];
    __syncthreads();
    for (int idx = tid; idx < 17 * 64; idx += 256) {
        const int r = idx >> 6, cc = idx & 63;
        const float v = s[(0 * 17 + r) * 64 + cc] + s[(1 * 17 + r) * 64 + cc] + s[(2 * 17 + r) * 64 + cc] + s[(3 * 17 + r) * 64 + cc];
        mod[((size_t)layer * 17 + r) * 6144 + n0 + cc] = v + p.ada_b[layer * 6144 + n0 + cc];
    }
}

template <bool ODMAP>
__device__ __forceinline__ void bias_item(const float* __restrict__ vec, const float* __restrict__ W, int ldw, float* __restrict__ out, int ldo, int n0, char* smem) {
    float* s = (float*)smem;
    const int tid = VTID;
    const int col = tid & 63, ks = tid >> 6;
    const int sc = ODMAP ? odmap(n0 + col) : n0 + col;
    float acc[17];
#pragma unroll
    for (int r = 0; r < 17; ++r) acc[r] = 0.f;
    for (int half = 0; half < 2; ++half) {
        __syncthreads();
        for (int idx = tid; idx < 17 * 512; idx += 256) {
            const int r = idx >> 9, k = (idx & 511) + half * 512;
            s[idx] = vec[(size_t)r * 6144 + k];
        }
        __syncthreads();
        const float* wp = W + (size_t)(half * 512 + ks * 128) * ldw + (sc >= 0 ? sc : 0);
        for (int k0 = 0; k0 < 128; k0 += 16) {
            float wv[16];
#pragma unroll
            for (int kk = 0; kk < 16; ++kk) wv[kk] = sc >= 0 ? wp[(size_t)(k0 + kk) * ldw] : 0.f;
#pragma unroll
            for (int kk = 0; kk < 16; ++kk)
#pragma unroll
                for (int r = 0; r < 17; ++r) acc[r] += s[r * 512 + ks * 128 + k0 + kk] * wv[kk];
        }
    }
    __syncthreads();
#pragma unroll
    for (int r = 0; r < 17; ++r) s[(ks * 17 + r) * 64 + col] = acc[r];
    __syncthreads();
    for (int idx = tid; idx < 17 * 64; idx += 256) {
        const int r = idx >> 6, cc = idx & 63;
        out[(size_t)r * ldo + n0 + cc] = s[(0 * 17 + r) * 64 + cc] + s[(1 * 17 + r) * 64 + cc] + s[(2 * 17 + r) * 64 + cc] + s[(3 * 17 + r) * 64 + cc];
    }
}

constexpr int P0_EV = (1792 / 64) * 16;
constexpr int P0_OD = (1536 / 64) * 16;
constexpr int P0_WO = 2 * 16 * 16;
constexpr int P0_W1 = 2 * 64 * 16;
constexpr int P0_W2 = 2 * 16 * 64;
constexpr int P0_UQ = (1792 / 64) * 6;
constexpr int P0_UKV = 0;
constexpr int P0_SGU = 128;
constexpr int P0_ZERO = 180;
constexpr int P0_ADA = 192;
constexpr int P0_TOTAL = P0_ADA + P0_EV + P0_OD + P0_WO + P0_W1 + P0_W2 + P0_UQ + P0_UKV + P0_SGU + P0_ZERO;

__device__ __forceinline__ void phase0_item(const Params& p, int it, char* smem) {
    char* ws = p.ws;
    if (it < P0_ADA) { ada_item(p, (float*)(ws + OFF_MOD), it, smem); return; }
    it -= P0_ADA;
    if (it < P0_EV) { tconv_tile<false, true>(p.ev_w_in, 1792, (bf16_t*)(ws + OFF_EVWIN), 1024, nullptr, it, smem); return; }
    it -= P0_EV;
    if (it < P0_OD) { tconv_tile<true, true>(p.od_w_in, 1440, (bf16_t*)(ws + OFF_ODWIN), 1024, nullptr, it, smem); return; }
    it -= P0_OD;
    if (it < P0_WO) { const int l = it / 256; tconv_tile<false, true>(p.w_out + (size_t)l * 1024 * 1024, 1024, (bf16_t*)(ws + OFF_WOUT) + (size_t)l * 1024 * 1024, 1024, nullptr, it % 256, smem); return; }
    it -= P0_WO;
    if (it < P0_W1) { const int l = it / 1024; tconv_tile<false, true>(p.mlp_w1 + (size_t)l * 1024 * 4096, 4096, (bf16_t*)(ws + OFF_W1) + (size_t)l * 4096 * 1024, 1024, nullptr, it % 1024, smem); return; }
    it -= P0_W1;
    if (it < P0_W2) { const int l = it / 1024; tconv_tile<false, true, true>(p.mlp_w2 + (size_t)l * 4096 * 1024, 1024, (bf16_t*)(ws + OFF_W2) + (size_t)l * 1024 * 4096, 4096, nullptr, it % 1024, smem, 1024); return; }
    it -= P0_W2;
    if (it < P0_UQ) { upw_tile(p, (bf16_t*)(ws + OFF_WUP), it, smem); return; }
    it -= P0_UQ;
    if (it < P0_SGU) {
        const int e = it * 1024 + VTID * 4;
        const f32x4 v = *(const f32x4*)(p.ev_sgu_w + e);
        store_bf16x4((bf16_t*)(ws + OFF_SGUW) + e, v[0], v[1], v[2], v[3]);
        return;
    }
    it -= P0_SGU;
    { *(f32x4*)((float*)(ws + OFF_SSQ) + it * 1024 + VTID * 4) = (f32x4){0.f, 0.f, 0.f, 0.f}; }
}

namespace pg8 {
#define PG8_LAS __attribute__((address_space(3)))
typedef unsigned short bf16_t;
typedef short bf16x8 __attribute__((ext_vector_type(8)));
typedef float f32x4 __attribute__((ext_vector_type(4)));
typedef unsigned u32x4 __attribute__((ext_vector_type(4)));
constexpr int BM = 256, BK = 64, HALF = 128, HTB = HALF * BK * 2  , STAGE_BYTES = 8 * HTB, NXCD = 8, WGM = 8;

__host__ __device__ __forceinline__ int lds_byte(int r, int c) { const int st = (r >> 4) * 2 + (c >> 5), rr = r & 15, cc = c & 31, ob = rr * 64 + cc * 2; return st * 1024 + (ob ^ (((ob >> 9) & 1) << 5)); }
__host__ __device__ __forceinline__ void stage_rc(int b, int& R, int& C) { const int st = b / 1024, sb = b % 1024, swz = sb ^ (((sb >> 9) & 1) << 5); R = (st >> 1) * 16 + swz / 64; C = (st & 1) * 32 + (swz % 64) / 2; }
__host__ __device__ __forceinline__ int perm32(int rho) { const int n = rho >> 4, i = rho & 15; return 8 * (i >> 2) + 4 * n + (i & 3); }

struct Unit { int pm, pn, ks; };
struct Gemm { const bf16_t* A; const bf16_t* Bt; int M, N, K; int a_tiled, b_tiled, a_rows; };

struct StaticOrder {
    int nM, nN, nwg, G, c;
    __host__ __device__ void init(int M, int N, int G_, int c_) { nM = M / BM; nN = N / BM; nwg = nM * nN; G = G_; c = c_; }
    __host__ __device__ bool next(int i, Unit& u) const {
        const long L = (long)i * G + c; if (L >= nwg) return false;
        int wgid = (int)L; { const int q = nwg / NXCD, r = nwg % NXCD, xcd = wgid % NXCD, off = wgid / NXCD; wgid = (xcd < r ? xcd * (q + 1) : r * (q + 1) + (xcd - r) * q) + off; }
        const int nig = WGM * nN, gid = wgid / nig, fm = gid * WGM, gsz = (nM - fm) < WGM ? (nM - fm) : WGM;
        u.pm = fm + ((wgid % nig) % gsz); u.pn = (wgid % nig) / gsz; u.ks = 0; return true;
    }
    __device__ __forceinline__ void a_ready(const Unit&) const {}
    __device__ __forceinline__ void done(const Unit&) const {}
};
template <class Epi, class Sched, bool STAMP = false>
__device__ __forceinline__ void gemm_phase(PG8_LAS unsigned char* lds, const Gemm g, const Sched& S, const Epi& E, unsigned long long* stamps) {
    const int tid = (int)fresh_tid(), wid = __builtin_amdgcn_readfirstlane(tid >> 6), lane = tid & 63, wr = wid >> 2, wc = wid & 3, fr = lane & 15, fq = lane >> 4;
    const int K = g.K, nt = K / BK;
    int ts_lo = 0, ts_hi = 0, nts = 0; const unsigned long long rt_entry = STAMP ? (unsigned long long)wall_clock64() : 0ull;
#define PG8_STAMP() do { if (STAMP && wid == 0 && nts < 64) { const unsigned long long _c = (unsigned long long)clock64(); \
        ts_lo = (lane == nts) ? (int)(unsigned)_c : ts_lo; ts_hi = (lane == nts) ? (int)(unsigned)(_c >> 32) : ts_hi; ++nts; } } while (0)
    PG8_STAMP();
    unsigned voffA[2], voffB[2];
#pragma unroll
    for (int i = 0; i < 2; ++i) { int R, C; stage_rc(tid * 16 + i * 8192, R, C); const int Rb = Epi::PERM ? ((R & ~31) + perm32(R & 31)) : R;
        voffA[i] = (unsigned)(R * (g.a_tiled ? 64 : K) + C) * 2u; voffB[i] = (unsigned)(Rb * (g.b_tiled ? 64 : K) + C) * 2u; }
    const size_t kstepA = g.a_tiled ? (size_t)g.a_rows * (BK * 2) : (size_t)(BK * 2), kstepB = g.b_tiled ? (size_t)g.N * (BK * 2) : (size_t)(BK * 2);
    const size_t hstepA = (size_t)HALF * (g.a_tiled ? BK : K) * 2, hstepB = (size_t)HALF * (g.b_tiled ? BK : K) * 2;
    const size_t tstepA = 2 * hstepA, tstepB = 2 * hstepB;
    const size_t ksplitA = (size_t)nt * kstepA, ksplitB = (size_t)nt * kstepB;
    const unsigned ldsw = (unsigned)wid * 1024u;
    const int aoff = lds_byte(wr * 64 + fr, fq * 8), boff = lds_byte(wc * 32 + fr, fq * 8);
#define PG8_SA(b, h) (((b) * 2 + (h)) * HTB)
#define PG8_SB(b, h) ((4 + (b) * 2 + (h)) * HTB)
#define PG8_STAGE(bufoff, gbase, voff) do { _Pragma("unroll") for (int _i = 0; _i < 2; ++_i) \
        __builtin_amdgcn_global_load_lds((const unsigned*)((const char*)(gbase) + (voff)[_i]), (PG8_LAS unsigned*)(lds + (bufoff) + ldsw + _i * 8192), 16, 0, 0); } while (0)
#define PG8_LDA(dst, b, h) do { _Pragma("unroll") for (int m = 0; m < 4; ++m) _Pragma("unroll") for (int k = 0; k < 2; ++k) dst[m][k] = *(const PG8_LAS bf16x8*)(lds + PG8_SA(b, h) + aoff + m * 2048 + k * 1024); } while (0)
#define PG8_LDB(dst, b, h) do { _Pragma("unroll") for (int n = 0; n < 2; ++n) _Pragma("unroll") for (int k = 0; k < 2; ++k) dst[n][k] = *(const PG8_LAS bf16x8*)(lds + PG8_SB(b, h) + boff + n * 2048 + k * 1024); } while (0)
#define PG8_MMA(ai, bj, At, Bt) do { __builtin_amdgcn_s_setprio(1); _Pragma("unroll") for (int m = 0; m < 4; ++m) _Pragma("unroll") for (int n = 0; n < 2; ++n) _Pragma("unroll") for (int k = 0; k < 2; ++k) \
        acc[ai][bj][m][n] = __builtin_amdgcn_mfma_f32_16x16x32_bf16(Bt[n][k], At[m][k], acc[ai][bj][m][n], 0, 0, 0); __builtin_amdgcn_s_setprio(0); } while (0)
#define PG8_WAIT_V(n) asm volatile("s_waitcnt vmcnt(" #n ")" ::: "memory")
#define PG8_WAIT_L(n) asm volatile("s_waitcnt lgkmcnt(" #n ")" ::: "memory")
#define PG8_BAR __builtin_amdgcn_s_barrier()
#define PG8_SCHED __builtin_amdgcn_sched_barrier(0)
    Unit cur, nxt; int ui = 0;
    if (!S.next(0, cur)) return;
    f32x4 acc[2][2][4][2];
#pragma unroll
    for (int a = 0; a < 2; ++a)
#pragma unroll
        for (int b = 0; b < 2; ++b)
#pragma unroll
            for (int m = 0; m < 4; ++m)
#pragma unroll
                for (int n = 0; n < 2; ++n) acc[a][b][m][n] = (f32x4){0.f, 0.f, 0.f, 0.f};
    bf16x8 At[4][2], B0[2][2], B1[2][2];
    const char* cA = (const char*)g.A + (size_t)cur.pm * tstepA + (size_t)cur.ks * ksplitA; const char* cB = (const char*)g.Bt + (size_t)cur.pn * tstepB + (size_t)cur.ks * ksplitB;
    S.a_ready(cur);
    PG8_STAGE(PG8_SB(0, 0), cB, voffB); PG8_STAGE(PG8_SA(0, 0), cA, voffA); PG8_STAGE(PG8_SB(0, 1), cB + hstepB, voffB); PG8_STAGE(PG8_SA(0, 1), cA + hstepA, voffA);
    if (wr == 1) PG8_BAR;
    PG8_WAIT_V(4); PG8_BAR;
    PG8_STAGE(PG8_SB(1, 0), cB + kstepB, voffB); PG8_STAGE(PG8_SA(1, 0), cA + kstepA, voffA); PG8_STAGE(PG8_SB(1, 1), cB + hstepB + kstepB, voffB);
    PG8_WAIT_V(6); PG8_BAR;
    PG8_STAMP();
    for (;;) {
        const bool has_next = S.next(ui + 1, nxt);
        const char* nA = has_next ? (const char*)g.A + (size_t)nxt.pm * tstepA + (size_t)nxt.ks * ksplitA : cA; const char* nB = has_next ? (const char*)g.Bt + (size_t)nxt.pn * tstepB + (size_t)nxt.ks * ksplitB : cB;
        for (int t = 0; t < nt; t += 2) {
            const bool last = (t == nt - 2);
            const char* a1 = cA + (size_t)(t + 1) * kstepA;
            const char* a2 = last ? nA : cA + (size_t)(t + 2) * kstepA; const char* b2 = last ? nB : cB + (size_t)(t + 2) * kstepB;
            const char* a3 = a2 + kstepA; const char* b3 = b2 + kstepB;
            if (last && has_next) S.a_ready(nxt);
            PG8_LDB(B0, 0, 0); PG8_SCHED; PG8_LDA(At, 0, 0); PG8_STAGE(PG8_SA(1, 1), a1 + hstepA, voffA);
            PG8_WAIT_L(8); PG8_BAR; PG8_WAIT_L(0); PG8_MMA(0, 0, At, B0); PG8_BAR; PG8_SCHED;
            PG8_LDB(B1, 0, 1); PG8_STAGE(PG8_SB(0, 0), b2, voffB);
            PG8_BAR; PG8_WAIT_L(0); PG8_MMA(0, 1, At, B1); PG8_BAR;
            PG8_LDA(At, 0, 1); PG8_STAGE(PG8_SA(0, 0), a2, voffA);
            PG8_BAR; PG8_WAIT_L(0); PG8_MMA(1, 0, At, B0); PG8_BAR; PG8_SCHED;
            PG8_STAGE(PG8_SB(0, 1), b2 + hstepB, voffB);
            PG8_WAIT_V(6); PG8_BAR; PG8_MMA(1, 1, At, B1); PG8_BAR;
            PG8_LDB(B0, 1, 0); PG8_SCHED; PG8_LDA(At, 1, 0); PG8_STAGE(PG8_SA(0, 1), a2 + hstepA, voffA);
            PG8_WAIT_L(8); PG8_BAR; PG8_WAIT_L(0); PG8_MMA(0, 0, At, B0); PG8_BAR; PG8_SCHED;
            PG8_LDB(B1, 1, 1); PG8_STAGE(PG8_SB(1, 0), b3, voffB);
            PG8_BAR; PG8_WAIT_L(0); PG8_MMA(0, 1, At, B1); PG8_BAR;
            PG8_LDA(At, 1, 1); PG8_STAGE(PG8_SA(1, 0), a3, voffA);
            PG8_BAR; PG8_WAIT_L(0); PG8_MMA(1, 0, At, B0); PG8_BAR; PG8_SCHED;
            PG8_STAGE(PG8_SB(1, 1), b3 + hstepB, voffB);
            PG8_WAIT_V(6); PG8_BAR; PG8_MMA(1, 1, At, B1); PG8_BAR;
        }
        PG8_STAMP();
        if constexpr (!Epi::AFTER_DRAIN) { E(acc, cur, wr, wc, fr, fq); S.done(cur); }
        PG8_STAMP();
        if (!has_next) break;
#pragma unroll
        for (int a = 0; a < 2; ++a)
#pragma unroll
            for (int b = 0; b < 2; ++b)
#pragma unroll
                for (int m = 0; m < 4; ++m)
#pragma unroll
                    for (int n = 0; n < 2; ++n) acc[a][b][m][n] = (f32x4){0.f, 0.f, 0.f, 0.f};
        cur = nxt; cA = nA; cB = nB; ++ui;
    }
    PG8_WAIT_V(0);
    if (wr == 0) PG8_BAR;
    PG8_BAR;
    if constexpr (Epi::AFTER_DRAIN) { E.fused(acc, cur, wr, wc, fr, fq, lds, wid, lane); S.done(cur); }
    PG8_STAMP();
    if (STAMP && wid == 0) { stamps[lane] = lane < nts ? (((unsigned long long)(unsigned)ts_hi << 32) | (unsigned)ts_lo) : 0ull;
        if (lane == 62) stamps[62] = rt_entry; if (lane == 63) stamps[63] = (unsigned long long)wall_clock64(); }
#undef PG8_STAMP
#undef PG8_SA
#undef PG8_SB
#undef PG8_STAGE
#undef PG8_LDA
#undef PG8_LDB
#undef PG8_MMA
#undef PG8_WAIT_V
#undef PG8_WAIT_L
#undef PG8_BAR
#undef PG8_SCHED
}
}
template <class E, class = void> struct has_staged { static constexpr bool value = false; };
template <class E> struct has_staged<E, decltype((void)E::STAGED)> { static constexpr bool value = true; };
template <class E> struct EpiAdapt {
    static constexpr bool PERM = false, AFTER_DRAIN = false;
    E e; char* stage_base;
    __device__ __forceinline__ void operator()(const f32x4 (&acc)[2][2][4][2], const pg8::Unit& u, int wr, int wc, int fr, int fq) const {
        { const int lane_ = (int)(fresh_tid() & 63u); fr = lane_ & 15; fq = lane_ >> 4; }
        const int m0 = u.pm * 256 + wr * 64, n0 = u.pn * 256 + wc * 64;
        if constexpr (has_staged<E>::value) {
            const int lane = fq * 16 + fr;
            char* stg = stage_base + (wr * 4 + wc) * 4096;
            const typename E::SState st = e.sbegin(m0, n0, lane, u.ks);
            typename E::SLoad q[3];
            q[0] = e.sload(m0, n0, lane);
            q[1] = e.sload(m0 + 16, n0, lane);
#pragma unroll
            for (int gi = 0; gi < 8; ++gi) {
                const int ai = gi >> 2, m = gi & 3;
                if (gi < 6) q[(gi + 2) % 3] = e.sload(m0 + ((gi + 2) >> 2) * 128 + ((gi + 2) & 3) * 16, n0, lane);
                f32x4 a[4] = {acc[ai][0][m][0], acc[ai][0][m][1], acc[ai][1][m][0], acc[ai][1][m][1]};
                e.srow(a, st, q[gi % 3], gi, m0 + ai * 128 + m * 16, n0, lane, stg);
            }
        } else {
            const typename E::State st = e.begin(m0, n0, fr, fq);
#pragma unroll
            for (int ai = 0; ai < 2; ++ai)
#pragma unroll
                for (int m = 0; m < 4; ++m) {
                    f32x4 a[4] = {acc[ai][0][m][0], acc[ai][0][m][1], acc[ai][1][m][0], acc[ai][1][m][1]};
                    e.row(a, st, ai * 4 + m, m0 + ai * 128 + m * 16, n0, fr, fq);
                }
        }
    }
};
struct SplitOrder4 {
    int nM, nN, nwg, G, c;
    __device__ void init(int M, int N, int G_, int c_) { nM = M / 256; nN = N / 256; nwg = nM * nN * 4; G = G_; c = c_; }
    __device__ bool next(int i, pg8::Unit& u) const {
        const int L = i * G + c; if (L >= nwg) return false;
        u.ks = L & 3; const int t = L >> 2; u.pm = t / nN; u.pn = t % nN; return true;
    }
    __device__ __forceinline__ void a_ready(const pg8::Unit&) const {}
    __device__ __forceinline__ void done(const pg8::Unit&) const {}
};
template <class E>
__device__ __forceinline__ void big_gemm_split4(const bf16_t* A, const bf16_t* Bt, int M, int N, int Kq, int a_rows, const E& e, char* smem) {
    SplitOrder4 S; S.init(M, N, (int)gridDim.x, (int)blockIdx.x);
    EpiAdapt<E> ea{e, smem + 131072};
    pg8::gemm_phase<EpiAdapt<E>, SplitOrder4, false>((PG8_LAS unsigned char*)smem, pg8::Gemm{A, Bt, M, N, Kq, 1, 1, a_rows}, S, ea, nullptr);
}
template <class E>
__device__ __forceinline__ void big_gemm(const bf16_t* A, const bf16_t* Bt, int M, int N, int K, const E& e, char* smem, int a_tiled = 0, int b_tiled = 0, int a_rows = 0) {
    pg8::StaticOrder S; S.init(M, N, (int)gridDim.x, (int)blockIdx.x);
    EpiAdapt<E> ea{e, smem + 131072};
    pg8::gemm_phase<EpiAdapt<E>, pg8::StaticOrder, false>((PG8_LAS unsigned char*)smem, pg8::Gemm{A, Bt, M, N, K, a_tiled, b_tiled, a_rows ? a_rows : M}, S, ea, nullptr);
}

#define XB_TMO      128
#define XB_XCNT(j)  (256  + 64 * (j))
#define XB_XSUB(j)  (1280 + 64 * (j))
#define XB_XGEN(j)  (2304 + 64 * (j))
#define XB_TOP      3328
#define XB_TOPGEN   3392
#define XCD_BAR_WORDS 3456
#define XB_SPIN_CAP (1u << 20)
#define LAS __attribute__((address_space(3)))
__device__ __forceinline__ unsigned xb_ld(unsigned* p)              { return __hip_atomic_load(p, __ATOMIC_RELAXED, __HIP_MEMORY_SCOPE_AGENT); }
__device__ __forceinline__ unsigned xb_add(unsigned* p, unsigned v) { return __hip_atomic_fetch_add(p, v, __ATOMIC_RELAXED, __HIP_MEMORY_SCOPE_AGENT); }
__device__ __forceinline__ unsigned xb_xcc_id() { return (unsigned)__builtin_amdgcn_s_getreg((3 << 11) | 20) & 0xFu; }
#define XB_SPIN(cond, bar) do { unsigned _sp = 0; while (cond) { __builtin_amdgcn_s_sleep(1); \
    if ((++_sp & 255u) == 0u) { if (xb_ld(&(bar)[XB_TMO])) break; if (_sp > XB_SPIN_CAP) { atomicAdd(&(bar)[XB_TMO], 1u); break; } } } } while (0)
#define XB_SLOTS 4096
#define XB_TOTAL_WORDS (4096 + 2048)
struct XcdBarrier { unsigned* bar; unsigned x; unsigned* st; };
__device__ __forceinline__ XcdBarrier xcd_barrier_post(unsigned* bar) {
    XcdBarrier b; b.bar = bar; b.x = xb_xcc_id(); b.st = bar + XB_SLOTS + 2 * blockIdx.x;
    if (threadIdx.x == 0) (void)xb_add(&bar[XB_XCNT(b.x)], 1u);
    return b;
}
__device__ __forceinline__ void xcd_barrier_complete(unsigned* bar, unsigned x, unsigned& nloc, unsigned& nx) {
    const unsigned G = gridDim.x * gridDim.y * gridDim.z;
    unsigned sum, cnt, mine, sp = 0u;
    for (;;) {
        sum = 0u; cnt = 0u; mine = 0u;
#pragma unroll
        for (unsigned j = 0; j < 16; ++j) { const unsigned c = xb_ld(&bar[XB_XCNT(j)]); sum += c; cnt += (c > 0u) ? 1u : 0u; mine = (j == x) ? c : mine; }
        if (sum == G) break;
        __builtin_amdgcn_s_sleep(1);
        if ((++sp & 255u) == 0u) { if (xb_ld(&bar[XB_TMO])) break; if (sp > XB_SPIN_CAP) { atomicAdd(&bar[XB_TMO], 1u); break; } }
    }
    nloc = mine > 0u ? mine : 1u; nx = cnt > 0u ? cnt : 1u;
}
__device__ __forceinline__ void xcd_barrier(const XcdBarrier& b) {
    asm volatile("s_waitcnt vmcnt(0)" ::: "memory");
    __syncthreads();
    if (threadIdx.x == 0) {
        unsigned* bar = b.bar;
        __builtin_amdgcn_s_waitcnt(0);
        unsigned nloc = b.st[0], nx = b.st[1];
        if (nloc == 0u) { xcd_barrier_complete(bar, b.x, nloc, nx); b.st[0] = nloc; b.st[1] = nx; }
        const unsigned old = xb_add(&bar[XB_XSUB(b.x)], 1u);
        const unsigned gen = old / nloc;
        if (old + 1u == (gen + 1u) * nloc) {
            __builtin_amdgcn_fence(__ATOMIC_RELEASE, "agent");
            asm volatile("s_waitcnt vmcnt(0)" ::: "memory");
            const unsigned og = xb_add(&bar[XB_TOP], 1u);
            const unsigned tg = og / nx;
            if (og + 1u == (tg + 1u) * nx) xb_add(&bar[XB_TOPGEN], 1u);
            else XB_SPIN(xb_ld(&bar[XB_TOPGEN]) == tg, bar);
            __builtin_amdgcn_fence(__ATOMIC_ACQUIRE, "agent");
            xb_add(&bar[XB_XGEN(b.x)], 1u);
            asm volatile("s_waitcnt vmcnt(0)" ::: "memory");
        } else {
            XB_SPIN(xb_ld(&bar[XB_XGEN(b.x)]) == gen, bar);
            __builtin_amdgcn_fence(__ATOMIC_ACQUIRE, "agent");
            asm volatile("s_waitcnt vmcnt(0)" ::: "memory");
        }
    }
    __syncthreads();
}

#define NPHASES 17
#define SMEM_BYTES 34816

template <bool DUP = false>
__device__ __forceinline__ void run_phase(const Params& p, int ph, char* smem0) {
    char* ws = p.ws;
    const int half_ = (int)(fresh_tid() >> 8);
    const int G = 2 * gridDim.x, B = 2 * blockIdx.x + half_;
    char* smem = smem0 + half_ * 65536;
    float* mod = (float*)(ws + OFF_MOD);
    float* xctx = (float*)(ws + OFF_XCTX);
    bf16_t* h = (bf16_t*)(ws + OFF_H);
    bf16_t* hid = (bf16_t*)(ws + OFF_HID);
    bf16_t* omix = (bf16_t*)(ws + OFF_OMIX);
    float* ssq_q = (float*)(ws + OFF_SSQ);
    float* ssq_kv = ssq_q + NTOK;
    float* ssq_a = ssq_q + 2 * NTOK;
    float* ssq_b = ssq_q + 3 * NTOK;
    float* ssq_c = ssq_q + 4 * NTOK;
    float* bias0 = (float*)(ws + OFF_BIAS);
    float* bias1 = bias0 + 17 * 4096;
    float* bias2 = bias1 + 17 * 1536;
    switch (ph) {
    case 0:
        for (int it = B; it < P0_TOTAL; it += G) phase0_item(p, it, smem);
        break;
    case 1:
        for (int it = B; it < 152 + NTOK / 4; it += G) {
            if (it < 64) bias_item<false>(mod + 3 * 1024, p.mlp_w1, 4096, bias0, 4096, it * 64, smem);
            else if (it < 88) bias_item<true>(mod + 17 * 6144, p.od_w_in, 1440, bias1, 1536, (it - 64) * 64, smem);
            else if (it < 152) bias_item<false>(mod + 17 * 6144 + 3 * 1024, p.mlp_w1 + (size_t)1024 * 4096, 4096, bias2, 4096, (it - 88) * 64, smem);
            else modulate_item(p.x, p.ctx, p.norm1_g, mod, 0, 1024, h, it - 152);
        }
        break;
    case 2: {
        EpiEvenIn e{(bf16_t*)(ws + OFF_Q), (bf16_t*)(ws + OFF_QC), (bf16_t*)(ws + OFF_K), (bf16_t*)(ws + OFF_VT), (bf16_t*)(ws + OFF_U),
                    (bf16_t*)(ws + OFF_VGT), p.ev_q_norm_g, p.ev_k_norm_g, p.ev_sgu_norm_g, smem0 + 131072};
        big_gemm(h, (const bf16_t*)(ws + OFF_EVWIN), NTOK, 1792, 1024, e, smem0);
    } break;
    case 3: {
        const int n1 = 16 * 8 * 8, n2 = 16 * 8 * 1, n3 = 8 * 144;
        const float cexp = 0.125f * 1.4426950408889634f;
        for (int it = blockIdx.x; it < n1 + n2; it += gridDim.x) {
            const bool lat = it < n1;
            attn_item<64>((const bf16_t*)(ws + (lat ? OFF_Q : OFF_QC)), (const bf16_t*)(ws + OFF_K), (const bf16_t*)(ws + OFF_VT), omix, lat ? it : it - n1,
                          lat ? 2048 : 256, lat ? LK : 256, 4, lat ? 0 : NLAT, cexp, smem0);
        }
        {
            const int h2 = (int)(fresh_tid() >> 8);
            char* sm2 = smem0 + h2 * 65536;
            for (int t = 2 * blockIdx.x + h2; t < n3; t += G) {
                const int g = t / 144, pn = t % 144;
                EpiGate e{(const bf16_t*)(ws + OFF_U), omix, p.ev_sgu_b + g * 128, g};
                gemm_tile((const bf16_t*)(ws + OFF_SGUW) + g * 16384, 128, (const bf16_t*)(ws + OFF_VGT) + (size_t)g * 288 * 64 * 128, 128, 128, 0, pn, e, sm2);
            }
        }
    } break;
    case 4: {
        EpiResid<true, DUP ? 1 : 0> e{p.x, p.ctx, p.out, xctx, mod + 2 * 1024, h, p.norm2_g, mod + 4 * 1024, ssq_a};
        big_gemm(omix, (const bf16_t*)(ws + OFF_WOUT), NTOK, 1024, 1024, e, smem0);
    } break;
    case 5:
        for (int it = B; it < NTOK / 4; it += G) modulate_item(p.out, xctx, p.norm2_g, mod, 3 * 1024, 4 * 1024, h, it);
        break;
    case 6: {
        EpiSqRelu e{hid, ssq_a, bias0, NTOK};
        big_gemm(h, (const bf16_t*)(ws + OFF_W1), NTOK, 4096, 1024, e, smem0);
    } break;
    case 7: {
        EpiResid<true, DUP ? 2 : 0> e{p.out, xctx, p.out, xctx, mod + 5 * 1024, h, p.norm1_g + 1024, mod + 17 * 6144 + 1024, ssq_b};
        big_gemm(hid, (const bf16_t*)(ws + OFF_W2), NLAT, 1024, 4096, e, smem0, 1, 1, NTOK);
        EpiPartial ep{(float*)(ws + OFF_PART), NCTX};
        big_gemm_split4(hid + (size_t)NLAT * 64, (const bf16_t*)(ws + OFF_W2), NCTX, 1024, 1024, NTOK, ep, smem0);
    } break;
    case 8:
        for (int it = B; it < NTOK / 4; it += G) modulate_item(p.out, xctx, p.norm1_g + 1024, mod + 17 * 6144, 0, 1024, h, it);
        break;
    case 9: {
        EpiOddIn<DUP ? 1 : 0> e{(bf16_t*)(ws + OFF_CQ), (bf16_t*)(ws + OFF_CKV), (bf16_t*)(ws + OFF_K2), (bf16_t*)(ws + OFF_GLU), ssq_q, ssq_b, bias1, smem0 + 131072};
        big_gemm(h, (const bf16_t*)(ws + OFF_ODWIN), NTOK, 1536, 1024, e, smem0);
    } break;
    case 10: {
        EpiUp e{(bf16_t*)(ws + OFF_Q2), (bf16_t*)(ws + OFF_K2), (bf16_t*)(ws + OFF_V2T), ssq_q, ssq_kv, smem0 + 131072};
        big_gemm((const bf16_t*)(ws + OFF_CQ), (const bf16_t*)(ws + OFF_WUP), NTOK, 1792, 384, e, smem0);
        {
            const int h2 = (int)(fresh_tid() >> 8);
            char* sm2 = smem0 + h2 * 65536;
            for (int it = 2 * blockIdx.x + h2; it < NLAT / 16; it += G) conv_item((const bf16_t*)(ws + OFF_GLU), p.od_conv_w, p.od_conv_b, p.od_ln_g, p.od_ln_b, omix, it, sm2);
        }
    } break;
    case 11: {
        const float cexp = 0.10206207261596575f * 1.4426950408889634f;
        for (int it = blockIdx.x; it < 16 * 8 * 8; it += gridDim.x)
            attn_item<96>((const bf16_t*)(ws + OFF_Q2), (const bf16_t*)(ws + OFF_K2), (const bf16_t*)(ws + OFF_V2T), omix, it, 2048, LK, 1, 0, cexp, smem0);
    } break;
    case 12: {
        EpiResid<true, DUP ? 2 : 0> e{p.out, xctx, p.out, xctx, mod + 17 * 6144 + 2 * 1024, h, p.norm2_g + 1024, mod + 17 * 6144 + 4 * 1024, ssq_c};
        big_gemm(omix, (const bf16_t*)(ws + OFF_WOUT) + 1024 * 1024, NLAT, 1024, 1024, e, smem0);
    } break;
    case 13:
        for (int it = B; it < NLAT / 4; it += G) modulate_item(p.out, xctx, p.norm2_g + 1024, mod + 17 * 6144, 3 * 1024, 4 * 1024, h, it);
        break;
    case 14: {
        EpiSqRelu e{hid, ssq_c, bias2, NLAT};
        big_gemm(h, (const bf16_t*)(ws + OFF_W1) + (size_t)4096 * 1024, NLAT, 4096, 1024, e, smem0);
    } break;
    case 15: {
        EpiResid<false, DUP ? 2 : 0> e{p.out, xctx, p.out, xctx, mod + 17 * 6144 + 5 * 1024, nullptr, nullptr, nullptr, nullptr};
        big_gemm(hid, (const bf16_t*)(ws + OFF_W2) + (size_t)1024 * 4096, NLAT, 1024, 4096, e, smem0, 1, 1);
    } break;
    case 17:
        for (int it = B; it < NCTX / 4; it += G)
            combine_item((const float*)(ws + OFF_PART), xctx, mod + 16 * 6144 + 5 * 1024, p.norm1_g + 1024, mod + 17 * 6144 + 16 * 6144 + 1024, h, ssq_b, it, DUP);
        break;
    case 16:
        for (int it = B; it < NLAT / 4; it += G) finalnorm_item(p.out, DUP ? (float*)(ws + OFF_BIG) : p.out, p.final_g, it);
        break;
    }
}

#define LDS_TOTAL (131072 + 32768)
#if MK_COOP
__global__ void __launch_bounds__(512, 2) mega_coop(Params p) {
    extern __shared__ __attribute__((aligned(16))) char smem[];
    cg::grid_group grid = cg::this_grid();
    XcdBarrier xb = xcd_barrier_post((unsigned*)(p.ws + OFF_BAR));
    if (p.ws == nullptr) grid.sync();
    run_phase(p, 0, smem);
    xcd_barrier(xb);
#ifndef DUP_A
#define DUP_A -1
#define DUP_B -1
#endif
#define PH(n) run_phase(p, n, smem); xcd_barrier(xb); if (n == DUP_A || n == DUP_B) { run_phase<true>(p, n, smem); xcd_barrier(xb); }
    PH(1) PH(2) PH(3) PH(4) PH(6) PH(7) PH(17) PH(9) PH(10) PH(11) PH(12) PH(14) PH(15)
#undef PH
    run_phase(p, 16, smem);
    if (DUP_A == 16) { xcd_barrier(xb); run_phase<true>(p, 16, smem); }
}
#else
__global__ void __launch_bounds__(512, 2) mega_phase(Params p, int ph) {
    extern __shared__ __attribute__((aligned(16))) char smem[];
#ifdef ONLY_PH
    run_phase(p, ONLY_PH, smem);
#else
    run_phase(p, ph, smem);
#endif
}
#endif

extern "C" void kernel_launch(void* const* d_in, const int* in_sizes, int n_in, void* d_out, int out_size, void* d_ws, size_t ws_size,
                              hipStream_t stream) {
    Params p{};
    const float** f = (const float**)&p;
    for (int i = 0; i < 27; ++i) f[i] = (const float*)d_in[i];
    p.out = (float*)d_out;
    p.ws = (char*)d_ws;
    static int grid_blocks = 0;
    if (!grid_blocks) {
        int dev = 0, cus = 0, per_cu = 0;
        (void)hipGetDevice(&dev);
        (void)hipDeviceGetAttribute(&cus, hipDeviceAttributeMultiprocessorCount, dev);
#if MK_COOP
        (void)hipFuncSetAttribute((const void*)mega_coop, hipFuncAttributeMaxDynamicSharedMemorySize, LDS_TOTAL);
        (void)hipOccupancyMaxActiveBlocksPerMultiprocessor(&per_cu, mega_coop, 512, LDS_TOTAL);
#else
        (void)hipFuncSetAttribute((const void*)mega_phase, hipFuncAttributeMaxDynamicSharedMemorySize, LDS_TOTAL);
        (void)hipOccupancyMaxActiveBlocksPerMultiprocessor(&per_cu, mega_phase, 512, LDS_TOTAL);
#endif
        if (per_cu < 1) per_cu = 1;
        if (per_cu > 1) per_cu = 1;
        grid_blocks = cus * per_cu;
    }
#if MK_COOP
    (void)hipMemsetAsync((char*)d_ws + OFF_BAR, 0, XB_TOTAL_WORDS * 4, stream);
    void* args[] = {&p};
    hipError_t e = hipLaunchCooperativeKernel((void*)mega_coop, dim3(grid_blocks), dim3(512), args, LDS_TOTAL, stream);
    if (e != hipSuccess) fprintf(stderr, "cooperative launch failed: %s (grid %d)\n", hipGetErrorString(e), grid_blocks);
#else
    for (int ph = 0; ph < NPHASES; ++ph) if (ph != 5 && ph != 8 && ph != 13) mega_phase<<<grid_blocks, 512, LDS_TOTAL, stream>>>(p, ph);
#endif
}
```

```cpp
#include <hip/hip_runtime.h>
#include <hip/hip_cooperative_groups.h>
#include <cstdio>
namespace cg = cooperative_groups;

#ifndef MK_COOP
#define MK_COOP 1
#endif

typedef unsigned short bf16_t;
typedef short bf16x8 __attribute__((ext_vector_type(8)));
typedef short bf16x4 __attribute__((ext_vector_type(4)));
typedef float f32x4 __attribute__((ext_vector_type(4)));
typedef unsigned u32x4 __attribute__((ext_vector_type(4)));
typedef unsigned u32x2 __attribute__((ext_vector_type(2)));

__device__ __forceinline__ unsigned fresh_tid() { unsigned t = threadIdx.x; asm volatile("" : "+v"(t)); return t; }
#define VTID ((int)(fresh_tid() & 255u))
#define NLAT 32768
#define NCTX 4096
#define NTOK 36864
#define LK 2304
#define EPSF 1e-6f
#define LOG2_THETA 13.287712379549449f

constexpr size_t al256(size_t x) { return (x + 255) & ~(size_t)255; }
constexpr size_t OFF_EVWIN = 0;
constexpr size_t OFF_ODWIN = OFF_EVWIN + al256((size_t)1792 * 1024 * 2);
constexpr size_t OFF_WOUT = OFF_ODWIN + al256((size_t)1536 * 1024 * 2);
constexpr size_t OFF_W1 = OFF_WOUT + al256((size_t)2 * 1024 * 1024 * 2);
constexpr size_t OFF_W2 = OFF_W1 + al256((size_t)2 * 4096 * 1024 * 2);
constexpr size_t OFF_WUQ = OFF_W2 + al256((size_t)2 * 4096 * 1024 * 2);
constexpr size_t OFF_WUKV = OFF_WUQ + al256((size_t)768 * 256 * 2);
constexpr size_t OFF_SGUW = OFF_WUKV + al256((size_t)1024 * 128 * 2);
constexpr size_t OFF_MOD = OFF_SGUW + al256((size_t)8 * 128 * 128 * 2);
constexpr size_t OFF_SSQ = OFF_MOD + al256((size_t)2 * 17 * 6144 * 4);
constexpr size_t OFF_BIAS = OFF_SSQ + al256((size_t)5 * NTOK * 16 * 4);
constexpr size_t OFF_XCTX = OFF_BIAS + al256((size_t)17 * (4096 + 1536 + 4096) * 4);
constexpr size_t OFF_H = OFF_XCTX + al256((size_t)NCTX * 1024 * 4);
constexpr size_t OFF_BIG = OFF_H + al256((size_t)NTOK * 1024 * 2);
constexpr size_t OFF_HID = OFF_BIG;
constexpr size_t OFF_OMIX = OFF_BIG;
constexpr size_t OFF_R = OFF_OMIX + al256((size_t)NTOK * 1024 * 2);
constexpr size_t OFF_Q = OFF_R;
constexpr size_t OFF_QC = OFF_Q + al256((size_t)16 * 8 * 2048 * 64 * 2);
constexpr size_t OFF_K = OFF_QC + al256((size_t)16 * 8 * 256 * 64 * 2);
constexpr size_t OFF_VT = OFF_K + al256((size_t)16 * 2 * LK * 64 * 2);
constexpr size_t OFF_U = OFF_VT + al256((size_t)16 * 2 * LK * 64 * 2);
constexpr size_t OFF_VGT = OFF_U + al256((size_t)NTOK * 512 * 2);
constexpr size_t OFF_CQ = OFF_R;
constexpr size_t OFF_CKV = OFF_CQ + al256((size_t)NTOK * 256 * 2);
constexpr size_t OFF_GLU = OFF_CKV + al256((size_t)NTOK * 128 * 2);
constexpr size_t OFF_Q2 = OFF_GLU + al256((size_t)NTOK * 512 * 2);
constexpr size_t OFF_K2 = OFF_Q2 + al256((size_t)16 * 8 * 2048 * 96 * 2);
constexpr size_t OFF_V2T = OFF_K2 + al256((size_t)16 * 8 * LK * 96 * 2);
constexpr size_t OFF_END1 = OFF_V2T + al256((size_t)16 * 8 * 64 * LK * 2);
constexpr size_t OFF_END = OFF_BIG + al256((size_t)NTOK * 4096 * 2);
static_assert(OFF_END1 <= OFF_END, "layer-1 scratch must fit under hid");
constexpr size_t OFF_BAR = OFF_END;
constexpr size_t OFF_WUP = OFF_BAR + 32768;
constexpr size_t OFF_PART = OFF_WUP + al256((size_t)1792 * 384 * 2);

struct Params {
    const float *x, *c, *ctx, *c_ctx, *ada_w, *ada_b, *norm1_g, *norm2_g, *w_out, *mlp_w1, *mlp_w2;
    const float *ev_w_in, *ev_q_norm_g, *ev_k_norm_g, *ev_sgu_norm_g, *ev_sgu_w, *ev_sgu_b;
    const float *od_w_in, *od_q_norm_g, *od_kv_norm_g, *od_w_uq, *od_w_ukv, *od_conv_w, *od_conv_b, *od_ln_g, *od_ln_b, *final_g;
    float* out;
    char* ws;
};

typedef __bf16 bf16x2_n __attribute__((ext_vector_type(2)));
typedef float f32x2_n __attribute__((ext_vector_type(2)));
__device__ __forceinline__ unsigned pack_bf16(float lo, float hi) {
    const f32x2_n v = {lo, hi};
    return __builtin_bit_cast(unsigned, __builtin_convertvector(v, bf16x2_n));
}
__device__ __forceinline__ bf16_t f2bf(float f) { return (bf16_t)(pack_bf16(f, 0.f) & 0xffffu); }
__device__ __forceinline__ float bf_lo(unsigned u) { return __uint_as_float(u << 16); }
__device__ __forceinline__ float bf_hi(unsigned u) { return __uint_as_float(u & 0xffff0000u); }
__device__ __forceinline__ void store_bf16x4(bf16_t* p, float a, float b, float c, float d) {
    u32x2 v; v.x = pack_bf16(a, b); v.y = pack_bf16(c, d);
    *(u32x2*)p = v;
}
__device__ __forceinline__ void store_bf16x4_nt(bf16_t* p, float a, float b, float c, float d) {
    u32x2 v; v.x = pack_bf16(a, b); v.y = pack_bf16(c, d);
    __builtin_nontemporal_store(v, (u32x2*)p);
}
__device__ __forceinline__ void store_f32x4_nt(float* p, f32x4 v) { __builtin_nontemporal_store(v, (f32x4*)p); }
__device__ __forceinline__ void tokinfo(int row, int& b, int& l, bool& isctx) {
    if (row < NLAT) { b = row >> 11; l = row & 2047; isctx = false; }
    else { int r = row - NLAT; b = r >> 8; l = r & 255; isctx = true; }
}
__device__ __forceinline__ float gelu_tanh(float x) {
    float u = 0.7978845608028654f * (x + 0.044715f * x * x * x);
    return x * __builtin_amdgcn_rcpf(1.f + __expf(-2.f * u));
}
__device__ __forceinline__ float sigmoidf_(float x) { return __builtin_amdgcn_rcpf(1.f + __expf(-x)); }
__device__ __forceinline__ void rot(float& x0, float& x1, float ang) {
    float rev = ang * 0.15915494309189535f;
    float s = __builtin_amdgcn_sinf(rev), c = __builtin_amdgcn_cosf(rev);
    float a = x0 * c - x1 * s, b = x0 * s + x1 * c;
    x0 = a; x1 = b;
}

__device__ __forceinline__ float ssq_sum(const float* __restrict__ p, int row, int nslots) {
    const f32x4* q = (const f32x4*)(p + (size_t)row * 16);
    f32x4 t = q[0];
    if (nslots > 4) { t += q[1]; t += q[2]; t += q[3]; }
    float s = t[0] + t[1];
    if (nslots > 2) s += t[2] + t[3];
    return s;
}

__device__ __forceinline__ float dpp_xor1(float x) { return __int_as_float(__builtin_amdgcn_update_dpp(0, __float_as_int(x), 0xB1, 0xf, 0xf, false)); }
__device__ __forceinline__ float dpp_xor2(float x) { return __int_as_float(__builtin_amdgcn_update_dpp(0, __float_as_int(x), 0x4E, 0xf, 0xf, false)); }
__device__ __forceinline__ void quad_transpose(float (&v)[4], int lane) {
    const bool odd = (lane & 1) != 0, hi = (lane & 2) != 0;
    const float sa = odd ? v[0] : v[1], sb = odd ? v[2] : v[3];
    const float ra = dpp_xor1(sa), rb = dpp_xor1(sb);
    const float n0 = odd ? ra : v[0], n1 = odd ? v[1] : ra, n2 = odd ? rb : v[2], n3 = odd ? v[3] : rb;
    const float ta = hi ? n0 : n2, tb = hi ? n1 : n3;
    const float ua = dpp_xor2(ta), ub = dpp_xor2(tb);
    v[0] = hi ? ua : n0; v[1] = hi ? ub : n1; v[2] = hi ? n2 : ua; v[3] = hi ? n3 : ub;
}

template <class Epi>
__device__ __forceinline__ void gemm_tile(const bf16_t* __restrict__ A, int lda, const bf16_t* __restrict__ Bt, int ldb, int K,
                                          int pm, int pn, const Epi& epi, char* smem) {
    bf16_t* sA = (bf16_t*)smem;
    bf16_t* sB = sA + 128 * 64;
    const int tid = VTID, lane = tid & 63, w = tid >> 6, wm = w >> 1, wn = w & 1, fr = lane & 15, fq = lane >> 4;
    const int srow = tid >> 3, skc = tid & 7;
    const bf16_t* Ag = A + (size_t)(pm * 128 + srow) * lda + skc * 8;
    const bf16_t* Bg = Bt + (size_t)(pn * 128 + srow) * ldb + skc * 8;
    const int swo = srow * 64 + ((skc ^ ((srow >> 1) & 7)) * 8);
    u32x4 ra[4], rb[4];
    f32x4 acc[4][4];
#pragma unroll
    for (int i = 0; i < 4; ++i)
#pragma unroll
        for (int j = 0; j < 4; ++j) acc[i][j] = (f32x4){0.f, 0.f, 0.f, 0.f};
#pragma unroll
    for (int i = 0; i < 4; ++i) {
        ra[i] = *(const u32x4*)(Ag + (size_t)(32 * i) * lda);
        rb[i] = *(const u32x4*)(Bg + (size_t)(32 * i) * ldb);
    }
    const int nk = K >> 6;
    const int sw = (fr >> 1) & 7;
    for (int kt = 0; kt < nk; ++kt) {
        __syncthreads();
#pragma unroll
        for (int i = 0; i < 4; ++i) {
            *(u32x4*)(sA + swo + i * 32 * 64) = ra[i];
            *(u32x4*)(sB + swo + i * 32 * 64) = rb[i];
        }
        __syncthreads();
        if (kt + 1 < nk) {
#pragma unroll
            for (int i = 0; i < 4; ++i) {
                ra[i] = *(const u32x4*)(Ag + (size_t)(32 * i) * lda + (kt + 1) * 64);
                rb[i] = *(const u32x4*)(Bg + (size_t)(32 * i) * ldb + (kt + 1) * 64);
            }
        }
#pragma unroll
        for (int kk = 0; kk < 2; ++kk) {
            bf16x8 af[4], bfr[4];
            const int co = ((kk * 4 + fq) ^ sw) * 8;
#pragma unroll
            for (int mi = 0; mi < 4; ++mi) af[mi] = *(const bf16x8*)(sA + (wm * 64 + mi * 16 + fr) * 64 + co);
#pragma unroll
            for (int ni = 0; ni < 4; ++ni) bfr[ni] = *(const bf16x8*)(sB + (wn * 64 + ni * 16 + fr) * 64 + co);
#pragma unroll
            for (int mi = 0; mi < 4; ++mi)
#pragma unroll
                for (int ni = 0; ni < 4; ++ni)
                    acc[mi][ni] = __builtin_amdgcn_mfma_f32_16x16x32_bf16(bfr[ni], af[mi], acc[mi][ni], 0, 0, 0);
        }
    }
    epi(acc, pm * 128 + wm * 64, pn * 128 + wn * 64, fr, fq);
}

template <int NCOLS>
__device__ __forceinline__ void wave_store_rows(char* stg, const u32x2* pk, bf16_t* base0, int stride, int fr, int fq) {
#pragma unroll
    for (int ni = 0; ni < NCOLS / 16; ++ni) *(u32x2*)(stg + fr * 136 + (ni * 16 + 4 * fq) * 2) = pk[ni];
    const int lane = fq * 16 + fr;
    if (NCOLS == 64) {
#pragma unroll
        for (int hh = 0; hh < 2; ++hh) {
            const int r = (lane >> 3) + 8 * hh, c = (lane & 7) * 8;
            const u32x2 a = *(const u32x2*)(stg + r * 136 + c * 2), b = *(const u32x2*)(stg + r * 136 + c * 2 + 8);
            *(u32x4*)(base0 + (size_t)r * stride + c) = (u32x4){a.x, a.y, b.x, b.y};
        }
    } else {
        const int r = lane >> 2, c = (lane & 3) * 8;
        const u32x2 a = *(const u32x2*)(stg + r * 136 + c * 2), b = *(const u32x2*)(stg + r * 136 + c * 2 + 8);
        *(u32x4*)(base0 + (size_t)r * stride + c) = (u32x4){a.x, a.y, b.x, b.y};
    }
}
__device__ __forceinline__ u32x2 pk4(float a, float b, float c, float d) { u32x2 v; v.x = pack_bf16(a, b); v.y = pack_bf16(c, d); return v; }
__device__ __forceinline__ char* wave_stage(char* stage_base) { return stage_base + (fresh_tid() >> 6) * 4096; }
struct NoState {};
#define EPI_NOSTATE                                                                                             \
    typedef NoState State;                                                                                      \
    __device__ __forceinline__ State begin(int, int, int, int) const { return State{}; }
#define EPI_CALL_ALL                                                                                            \
    __device__ __forceinline__ void operator()(f32x4 (&acc)[4][4], int m0, int n0, int fr, int fq) const {      \
        const State st = begin(m0, n0, fr, fq);                                                                 \
        _Pragma("unroll") for (int mi = 0; mi < 4; ++mi) row(acc[mi], st, mi, m0 + mi * 16, n0, fr, fq);           \
    }

struct EpiEvenIn {
    bf16_t *Q, *Qc, *K, *Vt, *U, *VgT;
    const float *qg, *kg, *sg; char* stage_base;
    struct State { f32x4 gv[4]; };
    __device__ __forceinline__ State begin(int m0, int n0, int fr, int fq) const {
        State st;
        const float* g = n0 < 512 ? qg : (n0 < 640 ? kg : (n0 >= 1280 ? sg + (n0 - 1280) : nullptr));
#pragma unroll
        for (int ni = 0; ni < 4; ++ni) st.gv[ni] = g ? *(const f32x4*)(g + ni * 16 + 4 * fq) : (f32x4){0.f, 0.f, 0.f, 0.f};
        return st;
    }
    __device__ __forceinline__ void row(f32x4 (&a)[4], const State& st, int gi, int rowbase, int n0, int fr, int fq) const {
        asm volatile("" : "+v"(fr), "+v"(fq));
        const int row = rowbase + fr;
        int b, l; bool isctx; tokinfo(row, b, l, isctx);
        if (n0 < 640) {
            const bool isq = n0 < 512;
            const int head = isq ? (n0 >> 6) : ((n0 - 512) >> 6);
            float ss = 0.f;
#pragma unroll
            for (int ni = 0; ni < 4; ++ni)
#pragma unroll
                for (int j = 0; j < 4; ++j) ss += a[ni][j] * a[ni][j];
            ss += __shfl_xor(ss, 16); ss += __shfl_xor(ss, 32);
            const float r = rsqrtf(ss * (1.f / 64.f) + EPSF);
            bf16_t* dst;
            if (isq) dst = isctx ? Qc + ((size_t)((b * 8 + head) * 256 + l)) * 64 : Q + ((size_t)((b * 8 + head) * 2048 + l)) * 64;
            else dst = K + ((size_t)((b * 2 + head) * LK + (isctx ? l : 256 + l))) * 64;
            const float frow = (float)(l >> 6), fcol = (float)(l & 63);
            u32x2 pk[4];
#pragma unroll
            for (int ni = 0; ni < 4; ++ni) {
                const f32x4 gv = st.gv[ni];
                float v[4];
#pragma unroll
                for (int j = 0; j < 4; ++j) v[j] = a[ni][j] * r * gv[j];
                if (!isctx) {
#pragma unroll
                    for (int p = 0; p < 2; ++p) {
                        const int i = ni * 8 + 2 * fq + p;
                        const float inv = __builtin_amdgcn_exp2f(-(float)(i & 15) * (LOG2_THETA / 16.f));
                        const float ang = (i < 16 ? frow : fcol) * inv;
                        rot(v[2 * p], v[2 * p + 1], ang);
                    }
                }
                pk[ni] = pk4(v[0], v[1], v[2], v[3]);
            }
            wave_store_rows<64>(wave_stage(stage_base), pk, dst - fr * 64, 64, fr, fq);
        } else if (n0 < 768) {
            const int hk = (n0 - 640) >> 6;
            const int pos = isctx ? l : 256 + l;
            bf16_t* dst = Vt + ((size_t)(b * 2 + hk) * 64 + 4 * fq + (fr & 3)) * LK + (pos - (fr & 3));
#pragma unroll
            for (int ni = 0; ni < 4; ++ni) {
                float v[4] = {a[ni][0], a[ni][1], a[ni][2], a[ni][3]};
                quad_transpose(v, fr);
                store_bf16x4(dst + (size_t)(ni * 16) * LK, v[0], v[1], v[2], v[3]);
            }
        } else {
            const int zc = n0 - 768;
            float v[4][4];
#pragma unroll
            for (int ni = 0; ni < 4; ++ni)
#pragma unroll
                for (int j = 0; j < 4; ++j) v[ni][j] = gelu_tanh(a[ni][j]);
            if (zc < 512) {
                u32x2 pk[4];
#pragma unroll
                for (int ni = 0; ni < 4; ++ni) pk[ni] = pk4(v[ni][0], v[ni][1], v[ni][2], v[ni][3]);
                wave_store_rows<64>(wave_stage(stage_base), pk, U + (size_t)rowbase * 512 + zc, 512, fr, fq);
            } else {
                const int g = (zc - 512) >> 6;
                float ss = 0.f;
#pragma unroll
                for (int ni = 0; ni < 4; ++ni)
#pragma unroll
                    for (int j = 0; j < 4; ++j) ss += v[ni][j] * v[ni][j];
                ss += __shfl_xor(ss, 16); ss += __shfl_xor(ss, 32);
                const float r = rsqrtf(ss * (1.f / 64.f) + EPSF);
                bf16_t* dst = VgT + ((size_t)(g * 288 + (row >> 7)) * 64 + 4 * fq + (fr & 3)) * 128 + ((row & 127) - (fr & 3));
#pragma unroll
                for (int ni = 0; ni < 4; ++ni) {
                    const f32x4 gv = st.gv[ni];
                    float t[4] = {v[ni][0] * r * gv[0], v[ni][1] * r * gv[1], v[ni][2] * r * gv[2], v[ni][3] * r * gv[3]};
                    quad_transpose(t, fr);
                    store_bf16x4(dst + (ni * 16) * 128, t[0], t[1], t[2], t[3]);
                }
            }
        }
    }
    EPI_CALL_ALL
};

__device__ __forceinline__ float row16_sum(float x) {
    x += __int_as_float(__builtin_amdgcn_update_dpp(0, __float_as_int(x), 0xB1, 0xf, 0xf, false));
    x += __int_as_float(__builtin_amdgcn_update_dpp(0, __float_as_int(x), 0x4E, 0xf, 0xf, false));
    x += __int_as_float(__builtin_amdgcn_update_dpp(0, __float_as_int(x), 0x141, 0xf, 0xf, false));
    x += __int_as_float(__builtin_amdgcn_update_dpp(0, __float_as_int(x), 0x140, 0xf, 0xf, false));
    return x;
}
__device__ __forceinline__ void stage_rows(f32x4 (&a)[4], f32x4 (&v)[4], char* stg, int lane) {
    const int fr = lane & 15, fq = lane >> 4;
#pragma unroll
    for (int ni = 0; ni < 4; ++ni) *(f32x4*)(stg + fr * 256 + (((4 * ni + fq) ^ fr) * 16)) = a[ni];
#pragma unroll
    for (int k = 0; k < 4; ++k) { const int r = fq + 4 * k; v[k] = *(const f32x4*)(stg + r * 256 + ((fr ^ r) * 16)); }
}

template <bool NEXT, int DUPM = 0>
struct EpiResid {
    const float *xin_lat, *xin_ctx; float *xout_lat, *xout_ctx; const float* gate;
    bf16_t* hA; const float* ng; const float* scp; float* ssq;
    struct State { f32x4 g[4]; f32x4 gs[4]; };
    __device__ __forceinline__ State begin(int m0, int n0, int fr, int fq) const {
        State st;
        const int mrow = m0 < NLAT ? (m0 >> 11) : 16;
#pragma unroll
        for (int ni = 0; ni < 4; ++ni) {
            st.g[ni] = *(const f32x4*)(gate + (size_t)mrow * 6144 + n0 + 4 * fq + ni * 16);
            if (DUPM == 2) st.g[ni] *= 0.f;
            if (NEXT) {
                const f32x4 n4 = *(const f32x4*)(ng + n0 + 4 * fq + ni * 16);
                const f32x4 s4 = *(const f32x4*)(scp + (size_t)mrow * 6144 + n0 + 4 * fq + ni * 16);
                st.gs[ni] = n4 * (s4 + 1.f);
            }
        }
        return st;
    }
    static constexpr bool STAGED = true;
    struct SState { f32x4 g, gs; };
    __device__ __forceinline__ SState sbegin(int m0, int n0, int lane, int) const {
        SState st;
        const int mrow = m0 < NLAT ? (m0 >> 11) : 16, c = n0 + 4 * (lane & 15);
        st.g = *(const f32x4*)(gate + (size_t)mrow * 6144 + c);
        if (DUPM == 2) st.g *= 0.f;
        if (NEXT) st.gs = *(const f32x4*)(ng + c) * (*(const f32x4*)(scp + (size_t)mrow * 6144 + c) + 1.f);
        return st;
    }
    struct SLoad { f32x4 x[4]; };
    __device__ __forceinline__ SLoad sload(int rowbase, int n0, int lane) const {
        SLoad L;
        const int c = n0 + 4 * (lane & 15);
        const bool isctx = rowbase >= NLAT;
        const float* xi0 = (isctx ? xin_ctx + (size_t)(rowbase - NLAT) * 1024 : xin_lat + (size_t)rowbase * 1024) + c;
#pragma unroll
        for (int k = 0; k < 4; ++k) L.x[k] = __builtin_nontemporal_load((const f32x4*)(xi0 + (size_t)((lane >> 4) + 4 * k) * 1024));
        return L;
    }
    __device__ __forceinline__ void srow(f32x4 (&a)[4], const SState& st, const SLoad& ld, int gi, int rowbase, int n0, int lane, char* stg) const {
        f32x4 v[4];
        stage_rows(a, v, stg, lane);
        const int c = n0 + 4 * (lane & 15);
        const bool isctx = rowbase >= NLAT;
        float* xo0 = (isctx ? xout_ctx + (size_t)(rowbase - NLAT) * 1024 : xout_lat + (size_t)rowbase * 1024) + c;
        const f32x4 (&x4)[4] = ld.x;
#pragma unroll
        for (int k = 0; k < 4; ++k) {
            const int r = (lane >> 4) + 4 * k;
            const f32x4 xn = x4[k] + st.g * v[k];
            if (NEXT) store_f32x4_nt(xo0 + (size_t)r * 1024, xn);
            else *(f32x4*)(xo0 + (size_t)r * 1024) = xn;
            if (NEXT) {
                const f32x4 hv = xn * st.gs;
                store_bf16x4(hA + (size_t)(rowbase + r) * 1024 + c, hv[0], hv[1], hv[2], hv[3]);
                const float ss = row16_sum(xn[0] * xn[0] + xn[1] * xn[1] + xn[2] * xn[2] + xn[3] * xn[3]);
                if ((lane & 15) == 0 && DUPM == 0) atomicAdd(ssq + rowbase + r, ss);
            }
        }
    }
    __device__ __forceinline__ void row(f32x4 (&a)[4], const State& st, int gi, int rowbase, int n0, int fr, int fq) const {
        const int row = rowbase + fr;
        const bool isctx = row >= NLAT;
        const float* xi = (isctx ? xin_ctx + (size_t)(row - NLAT) * 1024 : xin_lat + (size_t)row * 1024) + n0 + 4 * fq;
        float* xo = (isctx ? xout_ctx + (size_t)(row - NLAT) * 1024 : xout_lat + (size_t)row * 1024) + n0 + 4 * fq;
        float ss = 0.f;
#pragma unroll
        for (int ni = 0; ni < 4; ++ni) {
            const f32x4 x4 = *(const f32x4*)(xi + ni * 16);
            const f32x4 xn = x4 + st.g[ni] * a[ni];
            *(f32x4*)(xo + ni * 16) = xn;
            if (NEXT) {
                ss += xn[0] * xn[0] + xn[1] * xn[1] + xn[2] * xn[2] + xn[3] * xn[3];
                const f32x4 hv = xn * st.gs[ni];
                store_bf16x4(hA + (size_t)row * 1024 + n0 + 4 * fq + ni * 16, hv[0], hv[1], hv[2], hv[3]);
            }
        }
        if (NEXT) {
            ss += __shfl_xor(ss, 16); ss += __shfl_xor(ss, 32);
            if (fq == 0 && DUPM == 0) atomicAdd(ssq + row, ss);
        }
    }
    EPI_CALL_ALL
};

struct EpiPartial {
    float* part; int rows;
    static constexpr bool STAGED = true;
    struct SState { int ks; };
    __device__ __forceinline__ SState sbegin(int, int, int, int ks) const { return SState{ks}; }
    struct SLoad {};
    __device__ __forceinline__ SLoad sload(int, int, int) const { return SLoad{}; }
    __device__ __forceinline__ void srow(f32x4 (&a)[4], const SState& st, const SLoad&, int gi, int rowbase, int n0, int lane, char* stg) const {
        f32x4 v[4];
        stage_rows(a, v, stg, lane);
        float* dst = part + ((size_t)st.ks * rows + rowbase) * 1024 + n0 + 4 * (lane & 15);
#pragma unroll
        for (int k = 0; k < 4; ++k) *(f32x4*)(dst + (size_t)((lane >> 4) + 4 * k) * 1024) = v[k];
    }
};
__device__ __forceinline__ void combine_item(const float* __restrict__ part, float* __restrict__ xctx, const float* __restrict__ gate, const float* __restrict__ ng,
                                             const float* __restrict__ scp, bf16_t* __restrict__ hA, float* __restrict__ ssq, int item, bool dup) {
    const int lane = VTID & 63, w = VTID >> 6;
    const int r = item * 4 + w;
    float ss = 0.f;
#pragma unroll
    for (int i = 0; i < 4; ++i) {
        const int col = i * 256 + lane * 4;
        const size_t e = (size_t)r * 1024 + col;
        f32x4 sum = *(const f32x4*)(part + e);
        sum += *(const f32x4*)(part + (size_t)NCTX * 1024 + e);
        sum += *(const f32x4*)(part + (size_t)2 * NCTX * 1024 + e);
        sum += *(const f32x4*)(part + (size_t)3 * NCTX * 1024 + e);
        f32x4 g4 = *(const f32x4*)(gate + col);
        if (dup) g4 *= 0.f;
        const f32x4 xn = *(const f32x4*)(xctx + e) + g4 * sum;
        *(f32x4*)(xctx + e) = xn;
        const f32x4 hv = xn * (*(const f32x4*)(ng + col) * (*(const f32x4*)(scp + col) + 1.f));
        store_bf16x4(hA + (size_t)(NLAT + r) * 1024 + col, hv[0], hv[1], hv[2], hv[3]);
        ss += xn[0] * xn[0] + xn[1] * xn[1] + xn[2] * xn[2] + xn[3] * xn[3];
    }
#pragma unroll
    for (int o = 32; o >= 1; o >>= 1) ss += __shfl_xor(ss, o);
    if (lane == 0 && !dup) ssq[NLAT + r] = ss;
}

struct EpiSqRelu {
    bf16_t* hid; const float* ssq; const float* bias; int Mrows;
    static constexpr bool STAGED = true;
    struct SState { f32x4 b; float r0, r1; };
    __device__ __forceinline__ SState sbegin(int m0, int n0, int lane, int) const {
        SState st;
        const int mrow = m0 < NLAT ? (m0 >> 11) : 16;
        st.b = *(const f32x4*)(bias + (size_t)mrow * 4096 + n0 + 4 * (lane & 15));
        st.r0 = rsqrtf(ssq[m0 + lane] * (1.f / 1024.f) + EPSF);
        st.r1 = rsqrtf(ssq[m0 + 128 + lane] * (1.f / 1024.f) + EPSF);
        return st;
    }
    struct SLoad {};
    __device__ __forceinline__ SLoad sload(int, int, int) const { return SLoad{}; }
    __device__ __forceinline__ void srow(f32x4 (&a)[4], const SState& st, const SLoad&, int gi, int rowbase, int n0, int lane, char* stg) const {
        f32x4 v[4];
        stage_rows(a, v, stg, lane);
        const int c = n0 + 4 * (lane & 15);
        const float rsel = (gi >> 2) ? st.r1 : st.r0;
#pragma unroll
        for (int k = 0; k < 4; ++k) {
            const int r = (lane >> 4) + 4 * k;
            const float rs = __int_as_float(__builtin_amdgcn_ds_bpermute(4 * ((gi & 3) * 16 + r), __float_as_int(rsel)));
            float o[4];
#pragma unroll
            for (int j = 0; j < 4; ++j) { const float t = fmaxf(v[k][j] * rs + st.b[j], 0.f); o[j] = t * t; }
            store_bf16x4_nt(hid + ((size_t)(n0 >> 6) * Mrows + rowbase + r) * 64 + 4 * (lane & 15), o[0], o[1], o[2], o[3]);
        }
    }
    struct State { f32x4 b[4]; };
    __device__ __forceinline__ State begin(int m0, int n0, int fr, int fq) const {
        State st;
        const int mrow = m0 < NLAT ? (m0 >> 11) : 16;
#pragma unroll
        for (int ni = 0; ni < 4; ++ni) st.b[ni] = *(const f32x4*)(bias + (size_t)mrow * 4096 + n0 + 4 * fq + ni * 16);
        return st;
    }
    __device__ __forceinline__ void row(f32x4 (&a)[4], const State& st, int gi, int rowbase, int n0, int fr, int fq) const {
        const int row = rowbase + fr;
        const float r = rsqrtf(ssq[row] * (1.f / 1024.f) + EPSF);
#pragma unroll
        for (int ni = 0; ni < 4; ++ni) {
            const f32x4 b4 = st.b[ni];
            float v[4];
#pragma unroll
            for (int j = 0; j < 4; ++j) { float t = fmaxf(a[ni][j] * r + b4[j], 0.f); v[j] = t * t; }
            store_bf16x4(hid + ((size_t)(n0 >> 6) * Mrows + row) * 64 + ni * 16 + 4 * fq, v[0], v[1], v[2], v[3]);
        }
    }
    EPI_CALL_ALL
};

template <int DUPM = 0>
struct EpiOddIn {
    bf16_t *CQ, *CKV, *K2, *GLU; float* ssq;
    const float* ssq_in; const float* bias;
    char* stage_base;
    struct State { f32x4 b[4]; float r[8]; };
    __device__ __forceinline__ State begin(int m0, int n0, int fr, int fq) const {
        State st;
        const int mrow = m0 < NLAT ? (m0 >> 11) : 16;
#pragma unroll
        for (int ni = 0; ni < 4; ++ni) st.b[ni] = *(const f32x4*)(bias + (size_t)mrow * 1536 + n0 + 4 * fq + ni * 16);
#pragma unroll
        for (int gi = 0; gi < 8; ++gi) st.r[gi] = ssq_in[m0 + (gi >> 2) * 128 + (gi & 3) * 16 + fr];
#pragma unroll
        for (int gi = 0; gi < 8; ++gi) st.r[gi] = rsqrtf(st.r[gi] * (1.f / 1024.f) + EPSF);
        return st;
    }
    __device__ __forceinline__ void row(f32x4 (&a)[4], const State& st, int gi, int rowbase, int n0, int fr, int fq) const {
        const int row = rowbase + fr;
        {
            const float r_in = st.r[gi];
#pragma unroll
            for (int ni = 0; ni < 4; ++ni) a[ni] = a[ni] * r_in + st.b[ni];
        }
        if (n0 < 384) {
            const bool isq = n0 < 256;
            float ss = 0.f;
            u32x2 pk[4];
#pragma unroll
            for (int ni = 0; ni < 4; ++ni) {
#pragma unroll
                for (int j = 0; j < 4; ++j) ss += a[ni][j] * a[ni][j];
                pk[ni] = pk4(a[ni][0], a[ni][1], a[ni][2], a[ni][3]);
            }
            wave_store_rows<64>(wave_stage(stage_base), pk, CQ + (size_t)rowbase * 384 + n0, 384, fr, fq);
            ss += __shfl_xor(ss, 16); ss += __shfl_xor(ss, 32);
            if (fq == 0 && DUPM == 0) atomicAdd(ssq + (isq ? 0 : NTOK) + row, ss);
        } else if (n0 < 448) {
            int b, l; bool isctx; tokinfo(row, b, l, isctx);
            const int pos = isctx ? l : 256 + l;
            const float frow = (float)(l >> 6), fcol = (float)(l & 63);
#pragma unroll
            for (int ni = 0; ni < 2; ++ni) {
                float v[4];
#pragma unroll
                for (int j = 0; j < 4; ++j) v[j] = a[ni][j];
                if (!isctx) {
#pragma unroll
                    for (int p = 0; p < 2; ++p) {
                        const int i = ni * 8 + 2 * fq + p;
                        const float inv = __builtin_amdgcn_exp2f(-(float)(i & 7) * (LOG2_THETA / 8.f));
                        rot(v[2 * p], v[2 * p + 1], (i < 8 ? frow : fcol) * inv);
                    }
                }
#pragma unroll
                for (int h = 0; h < 8; ++h)
                    store_bf16x4(K2 + ((size_t)((b * 8 + h) * LK + pos)) * 96 + 64 + ni * 16 + 4 * fq, v[0], v[1], v[2], v[3]);
            }
        } else if (n0 >= 512) {
            const int wt = (n0 - 512) >> 6;
            u32x2 pk[2];
#pragma unroll
            for (int ni = 0; ni < 2; ++ni) {
                float v[4];
#pragma unroll
                for (int j = 0; j < 4; ++j) v[j] = a[ni][j] * sigmoidf_(a[ni + 2][j]);
                pk[ni] = pk4(v[0], v[1], v[2], v[3]);
            }
            wave_store_rows<32>(wave_stage(stage_base), pk, GLU + (size_t)rowbase * 512 + wt * 32, 512, fr, fq);
        }
    }
    EPI_CALL_ALL
};

struct EpiUp {
    bf16_t *Q2, *K2, *V2t; const float *ssq_q, *ssq_kv; char* stage_base;
    struct State { float r[8]; };
    __device__ __forceinline__ State begin(int m0, int n0, int fr, int fq) const {
        State st;
        const bool isq = n0 < 768;
        const float* sp = isq ? ssq_q : ssq_kv;
        const float sc = isq ? (1.f / 256.f) : (1.f / 128.f);
#pragma unroll
        for (int gi = 0; gi < 8; ++gi) st.r[gi] = sp[m0 + (gi >> 2) * 128 + (gi & 3) * 16 + fr];
#pragma unroll
        for (int gi = 0; gi < 8; ++gi) st.r[gi] = rsqrtf(st.r[gi] * sc + EPSF);
        return st;
    }
    __device__ __forceinline__ void row(f32x4 (&a)[4], const State& st, int gi, int rowbase, int n0, int fr, int fq) const {
        asm volatile("" : "+v"(fr), "+v"(fq));
        const int row = rowbase + fr;
        const float r = st.r[gi];
        if (n0 < 768) {
            if (rowbase >= NLAT) return;
            const int b = row >> 11, l = row & 2047;
            const float frow = (float)(l >> 6), fcol = (float)(l & 63);
#pragma unroll
            for (int ni = 0; ni < 4; ++ni) {
                const int col = n0 + ni * 16 + 4 * fq;
                const int h = col / 96, d = col - h * 96;
                float v[4];
#pragma unroll
                for (int j = 0; j < 4; ++j) v[j] = a[ni][j] * r;
                if (d >= 64) {
#pragma unroll
                    for (int p = 0; p < 2; ++p) {
                        const int i = ((d - 64) >> 1) + p;
                        const float inv = __builtin_amdgcn_exp2f(-(float)(i & 7) * (LOG2_THETA / 8.f));
                        rot(v[2 * p], v[2 * p + 1], (i < 8 ? frow : fcol) * inv);
                    }
                }
                store_bf16x4(Q2 + ((size_t)((b * 8 + h) * 2048 + l)) * 96 + d, v[0], v[1], v[2], v[3]);
            }
        } else {
            const int nk = n0 - 768;
            const int h = nk >> 7;
            const bool isv = (nk & 64) != 0;
            int b, l; bool isctx; tokinfo(row, b, l, isctx);
            const int pos = isctx ? l : 256 + l;
            if (!isv) {
                bf16_t* dst = K2 + ((size_t)((b * 8 + h) * LK + pos)) * 96;
                u32x2 pk[4];
#pragma unroll
                for (int ni = 0; ni < 4; ++ni) pk[ni] = pk4(a[ni][0] * r, a[ni][1] * r, a[ni][2] * r, a[ni][3] * r);
                wave_store_rows<64>(wave_stage(stage_base), pk, dst - fr * 96, 96, fr, fq);
            } else {
                bf16_t* dst = V2t + ((size_t)(b * 8 + h) * 64 + 4 * fq + (fr & 3)) * LK + (pos - (fr & 3));
#pragma unroll
                for (int ni = 0; ni < 4; ++ni) {
                    float v[4] = {a[ni][0] * r, a[ni][1] * r, a[ni][2] * r, a[ni][3] * r};
                    quad_transpose(v, fr);
                    store_bf16x4(dst + (size_t)(ni * 16) * LK, v[0], v[1], v[2], v[3]);
                }
            }
        }
    }
};

struct EpiGate {
    const bf16_t* U; bf16_t* Omix; const float* bias; int g;
    EPI_NOSTATE
    __device__ __forceinline__ void row(f32x4 (&a)[4], const State& st, int gi, int rowbase, int n0, int fr, int fq) const {
        const int pp = rowbase + fr;
        const float bs = bias[pp];
#pragma unroll
        for (int ni = 0; ni < 4; ++ni) {
            const int col = n0 + ni * 16 + 4 * fq;
            const int chunk = col >> 6, c = col & 63;
            const size_t tok = (size_t)chunk * 128 + pp;
            const u32x2 u = *(const u32x2*)(U + tok * 512 + g * 64 + c);
            store_bf16x4(Omix + tok * 1024 + 512 + g * 64 + c, (a[ni][0] + bs) * bf_lo(u.x), (a[ni][1] + bs) * bf_hi(u.x),
                         (a[ni][2] + bs) * bf_lo(u.y), (a[ni][3] + bs) * bf_hi(u.y));
        }
    }
    EPI_CALL_ALL
};

__device__ __forceinline__ float rows_max(float x) {
    unsigned u = __float_as_uint(x);
    u32x2 r = __builtin_amdgcn_permlane16_swap(u, u, false, false);
    const float m = fmaxf(__uint_as_float(r.x), __uint_as_float(r.y));
    u = __float_as_uint(m);
    r = __builtin_amdgcn_permlane32_swap(u, u, false, false);
    return fmaxf(__uint_as_float(r.x), __uint_as_float(r.y));
}
__device__ __forceinline__ float rows_sum(float x) {
    unsigned u = __float_as_uint(x);
    u32x2 r = __builtin_amdgcn_permlane16_swap(u, u, false, false);
    const float m = __uint_as_float(r.x) + __uint_as_float(r.y);
    u = __float_as_uint(m);
    r = __builtin_amdgcn_permlane32_swap(u, u, false, false);
    return __uint_as_float(r.x) + __uint_as_float(r.y);
}

template <int DQK>
__device__ __forceinline__ void attn_item(const bf16_t* __restrict__ Qb, const bf16_t* __restrict__ Kb, const bf16_t* __restrict__ Vtb,
                                          bf16_t* __restrict__ Omix, int item, int Lq, int nkeys, int hk_div, int rowbase, float cexp, char* smem) {
    constexpr int KSTR = (DQK == 64) ? 64 : 128;
    constexpr int NDC = DQK / 32;
    constexpr int KCH = DQK / 8;
    constexpr int NC = 64 * KCH;
    constexpr int NKL = (NC + 511) / 512;
    constexpr int BUFE = 64 * KSTR + 64 * 72;
    bf16_t* const sbase = (bf16_t*)smem;
    const int tid = (int)fresh_tid(), lane = tid & 63, w = tid >> 6, fr = lane & 15, fq = lane >> 4;
    const int nqt = Lq >> 8;
    const int qt = item % nqt, h = (item / nqt) & 7, b = item / (nqt * 8);
    const int nkvh = 8 / hk_div, hk = h / hk_div;
    const bf16_t* Qp = Qb + ((size_t)((b * 8 + h) * Lq + qt * 256 + w * 32)) * DQK;
    const bf16_t* Kp = Kb + (size_t)(b * nkvh + hk) * LK * DQK;
    const bf16_t* Vp = Vtb + (size_t)(b * nkvh + hk) * 64 * LK;

    bf16x8 qf[2][NDC];
#pragma unroll
    for (int qb = 0; qb < 2; ++qb)
#pragma unroll
        for (int dc = 0; dc < NDC; ++dc) {
            const u32x4 q4 = *(const u32x4*)(Qp + (qb * 16 + fr) * DQK + dc * 32 + fq * 8);
            u32x4 r4;
#pragma unroll
            for (int e = 0; e < 4; ++e) r4[e] = pack_bf16(bf_lo(q4[e]) * cexp, bf_hi(q4[e]) * cexp);
            qf[qb][dc] = __builtin_bit_cast(bf16x8, r4);
        }

    int koff_g[NKL], koff_s[NKL];
#pragma unroll
    for (int i = 0; i < NKL; ++i) {
        const int c = (tid + 512 * i) < NC ? tid + 512 * i : tid, row = c / KCH, ch = c % KCH;
        koff_g[i] = row * DQK + ch * 8;
        koff_s[i] = (DQK == 64) ? row * 64 + ((ch ^ ((row >> 1) & 7)) * 8) : row * 128 + ((ch ^ (row & 15)) * 8);
    }
    u32x4 rk[NKL], rv[2];
#pragma unroll
    for (int i = 0; i < NKL; ++i) rk[i] = *(const u32x4*)(Kp + koff_g[i]);
#pragma unroll
    for (int i = 0; i < 1; ++i) { const int c = tid; rv[i] = *(const u32x4*)(Vp + (size_t)(c >> 3) * LK + (c & 7) * 8); }

    f32x4 o[2][5];
    float m[2];
#pragma unroll
    for (int qb = 0; qb < 2; ++qb) {
        m[qb] = -1e30f;
#pragma unroll
        for (int d = 0; d < 5; ++d) o[qb][d] = (f32x4){0.f, 0.f, 0.f, 0.f};
    }
    const u32x4 ones_u = {0x3F803F80u, 0x3F803F80u, 0x3F803F80u, 0x3F803F80u};
    const bf16x8 ones = __builtin_bit_cast(bf16x8, ones_u);
    const int nt = nkeys >> 6;
    {
#pragma unroll
        for (int i = 0; i < NKL; ++i) *(u32x4*)(sbase + koff_s[i]) = rk[i];
#pragma unroll
        for (int i = 0; i < 1; ++i) { const int c = tid; *(u32x4*)(sbase + 64 * KSTR + (c >> 3) * 72 + (c & 7) * 8) = rv[i]; }
#pragma unroll
        for (int i = 0; i < NKL; ++i) rk[i] = *(const u32x4*)(Kp + (size_t)64 * DQK + koff_g[i]);
#pragma unroll
        for (int i = 0; i < 1; ++i) { const int c = tid; rv[i] = *(const u32x4*)(Vp + (size_t)(c >> 3) * LK + 64 + (c & 7) * 8); }
    }
    __syncthreads();
    for (int kt = 0; kt < nt; ++kt) {
        const bf16_t* sK = sbase + (kt & 1) * BUFE;
        const bf16_t* sV = sK + 64 * KSTR;
        f32x4 s[2][4];
#pragma unroll
        for (int kb = 0; kb < 4; ++kb) {
#pragma unroll
            for (int qb = 0; qb < 2; ++qb) s[qb][kb] = (f32x4){0.f, 0.f, 0.f, 0.f};
#pragma unroll
            for (int dc = 0; dc < NDC; ++dc) {
                const int row = kb * 16 + fr, ch = dc * 4 + fq;
                const int off = (DQK == 64) ? row * 64 + ((ch ^ ((row >> 1) & 7)) * 8) : row * 128 + ((ch ^ (row & 15)) * 8);
                const bf16x8 kf = *(const bf16x8*)(sK + off);
#pragma unroll
                for (int qb = 0; qb < 2; ++qb) s[qb][kb] = __builtin_amdgcn_mfma_f32_16x16x32_bf16(kf, qf[qb][dc], s[qb][kb], 0, 0, 0);
            }
        }
        if (kt + 1 < nt) {
            bf16_t* nK = sbase + ((kt + 1) & 1) * BUFE;
#pragma unroll
            for (int i = 0; i < NKL; ++i) *(u32x4*)(nK + koff_s[i]) = rk[i];
#pragma unroll
            for (int i = 0; i < 1; ++i) { const int c = tid; *(u32x4*)(nK + 64 * KSTR + (c >> 3) * 72 + (c & 7) * 8) = rv[i]; }
            if (kt + 2 < nt) {
#pragma unroll
                for (int i = 0; i < NKL; ++i) rk[i] = *(const u32x4*)(Kp + (size_t)(kt + 2) * 64 * DQK + koff_g[i]);
#pragma unroll
                for (int i = 0; i < 1; ++i) { const int c = tid; rv[i] = *(const u32x4*)(Vp + (size_t)(c >> 3) * LK + (kt + 2) * 64 + (c & 7) * 8); }
            }
        }
        bf16x8 pb[2][2];
#pragma unroll
        for (int qb = 0; qb < 2; ++qb) {
            float mx = s[qb][0][0];
#pragma unroll
            for (int kb = 0; kb < 4; ++kb)
#pragma unroll
                for (int j = 0; j < 4; ++j) mx = fmaxf(mx, s[qb][kb][j]);
            mx = rows_max(mx);
            const float mnew = fmaxf(m[qb], mx);
            const float alpha = __builtin_amdgcn_exp2f(m[qb] - mnew);
            m[qb] = mnew;
            unsigned pk[8];
#pragma unroll
            for (int kb = 0; kb < 4; ++kb) {
                const f32x4 d = s[qb][kb] - mnew;
                const float p0 = __builtin_amdgcn_exp2f(d[0]), p1 = __builtin_amdgcn_exp2f(d[1]);
                const float p2 = __builtin_amdgcn_exp2f(d[2]), p3 = __builtin_amdgcn_exp2f(d[3]);
                pk[kb * 2] = pack_bf16(p0, p1); pk[kb * 2 + 1] = pack_bf16(p2, p3);
            }
            u32x4 t0 = {pk[0], pk[1], pk[2], pk[3]}, t1 = {pk[4], pk[5], pk[6], pk[7]};
            pb[qb][0] = __builtin_bit_cast(bf16x8, t0);
            pb[qb][1] = __builtin_bit_cast(bf16x8, t1);
            if (__builtin_amdgcn_ballot_w64(alpha != 1.f) != 0ull) {
#pragma unroll
                for (int d = 0; d < 5; ++d) o[qb][d] *= alpha;
            }
        }
#pragma unroll
        for (int dvb = 0; dvb < 4; ++dvb)
#pragma unroll
            for (int ks = 0; ks < 2; ++ks) {
                const bf16_t* vp = sV + (dvb * 16 + fr) * 72 + ks * 32 + fq * 4;
                const u32x2 v0 = *(const u32x2*)vp, v1 = *(const u32x2*)(vp + 16);
                    u32x4 t = {v0.x, v0.y, v1.x, v1.y};
                const bf16x8 vf = __builtin_bit_cast(bf16x8, t);
#pragma unroll
                for (int qb = 0; qb < 2; ++qb) o[qb][dvb] = __builtin_amdgcn_mfma_f32_16x16x32_bf16(vf, pb[qb][ks], o[qb][dvb], 0, 0, 0);
            }
#pragma unroll
        for (int ks = 0; ks < 2; ++ks)
#pragma unroll
            for (int qb = 0; qb < 2; ++qb) o[qb][4] = __builtin_amdgcn_mfma_f32_16x16x32_bf16(ones, pb[qb][ks], o[qb][4], 0, 0, 0);
        __syncthreads();
    }
#pragma unroll
    for (int qb = 0; qb < 2; ++qb) {
        const float inv = 1.f / o[qb][4][0];
        const size_t row = (size_t)rowbase + (size_t)b * Lq + qt * 256 + w * 32 + qb * 16 + fr;
#pragma unroll
        for (int dvb = 0; dvb < 4; ++dvb)
            store_bf16x4(Omix + row * 1024 + h * 64 + dvb * 16 + fq * 4, o[qb][dvb][0] * inv, o[qb][dvb][1] * inv, o[qb][dvb][2] * inv, o[qb][dvb][3] * inv);
    }
}

__device__ __forceinline__ void conv_item(const bf16_t* __restrict__ GLU, const float* __restrict__ cw, const float* __restrict__ cb,
                                          const float* __restrict__ lg, const float* __restrict__ lb, bf16_t* __restrict__ Omix, int item, char* smem) {
    float* ys = (float*)smem;
    const int tid = VTID, lane = tid & 63, w = tid >> 6;
    const int ch = 2 * tid;
    const int tok0 = item * 16, b = tok0 >> 11, l0 = tok0 & 2047;
    const bf16_t* gp = GLU + ((size_t)b * 2048) * 512 + ch;
    float w0[31], w1[31];
#pragma unroll
    for (int j = 0; j < 31; ++j) { const float2 t = *(const float2*)(cw + j * 512 + ch); w0[j] = t.x; w1[j] = t.y; }
    const float2 cbv = *(const float2*)(cb + ch);
    unsigned win[31];
#pragma unroll
    for (int j = 0; j < 31; ++j) {
        const int l = l0 - 15 + j;
        win[j] = (l >= 0 && l < 2048) ? *(const unsigned*)(gp + (size_t)l * 512) : 0u;
    }
    __syncthreads();
#pragma unroll 1
    for (int t = 0; t < 16; ++t) {
        float a0 = cbv.x, a1 = cbv.y;
#pragma unroll
        for (int j = 0; j < 31; ++j) { a0 += w0[j] * bf_lo(win[j]); a1 += w1[j] * bf_hi(win[j]); }
        *(float2*)(ys + t * 512 + ch) = make_float2(a0, a1);
        const int l = l0 + t + 16;
        const unsigned nx = (l < 2048) ? *(const unsigned*)(gp + (size_t)l * 512) : 0u;
#pragma unroll
        for (int j = 0; j < 30; ++j) win[j] = win[j + 1];
        win[30] = nx;
    }
    __syncthreads();
#pragma unroll 1
    for (int t = w; t < 16; t += 4) {
        const f32x4 v0 = *(const f32x4*)(ys + t * 512 + lane * 8), v1 = *(const f32x4*)(ys + t * 512 + lane * 8 + 4);
        float sm = (v0[0] + v0[1]) + (v0[2] + v0[3]) + (v1[0] + v1[1]) + (v1[2] + v1[3]);
#pragma unroll
        for (int o = 32; o >= 1; o >>= 1) sm += __shfl_xor(sm, o);
        const float mean = sm * (1.f / 512.f);
        float d[8];
        float sq = 0.f;
#pragma unroll
        for (int j = 0; j < 4; ++j) { d[j] = v0[j] - mean; d[4 + j] = v1[j] - mean; }
#pragma unroll
        for (int j = 0; j < 8; ++j) sq += d[j] * d[j];
#pragma unroll
        for (int o = 32; o >= 1; o >>= 1) sq += __shfl_xor(sq, o);
        const float r = rsqrtf(sq * (1.f / 512.f) + EPSF);
        const f32x4 g0 = *(const f32x4*)(lg + lane * 8), g1 = *(const f32x4*)(lg + lane * 8 + 4);
        const f32x4 b0 = *(const f32x4*)(lb + lane * 8), b1 = *(const f32x4*)(lb + lane * 8 + 4);
        float o_[8];
#pragma unroll
        for (int j = 0; j < 4; ++j) { o_[j] = d[j] * r * g0[j] + b0[j]; o_[4 + j] = d[4 + j] * r * g1[j] + b1[j]; }
#pragma unroll
        for (int j = 0; j < 8; ++j) o_[j] = o_[j] * sigmoidf_(o_[j]);
        u32x4 pk = {pack_bf16(o_[0], o_[1]), pack_bf16(o_[2], o_[3]), pack_bf16(o_[4], o_[5]), pack_bf16(o_[6], o_[7])};
        *(u32x4*)(Omix + (size_t)(tok0 + t) * 1024 + 512 + lane * 8) = pk;
    }
}

__device__ __forceinline__ void modulate_item(const float* __restrict__ xlat, const float* __restrict__ xctx, const float* __restrict__ ng,
                                              const float* __restrict__ modl, int sh_off, int sc_off, bf16_t* __restrict__ h, int item) {
    const int lane = VTID & 63, w = VTID >> 6;
    const int row = item * 4 + w;
    int b, l; bool isctx; tokinfo(row, b, l, isctx);
    const float* x = isctx ? xctx + (size_t)(row - NLAT) * 1024 : xlat + (size_t)row * 1024;
    const float* mp = modl + (size_t)(isctx ? 16 : b) * 6144;
    f32x4 v[4];
    float ss = 0.f;
#pragma unroll
    for (int i = 0; i < 4; ++i) {
        v[i] = *(const f32x4*)(x + i * 256 + lane * 4);
        ss += v[i][0] * v[i][0] + v[i][1] * v[i][1] + v[i][2] * v[i][2] + v[i][3] * v[i][3];
    }
#pragma unroll
    for (int o = 32; o >= 1; o >>= 1) ss += __shfl_xor(ss, o);
    const float r = rsqrtf(ss * (1.f / 1024.f) + EPSF);
#pragma unroll
    for (int i = 0; i < 4; ++i) {
        const int col = i * 256 + lane * 4;
        const f32x4 g4 = *(const f32x4*)(ng + col), sc = *(const f32x4*)(mp + sc_off + col), sh = *(const f32x4*)(mp + sh_off + col);
        float y[4];
#pragma unroll
        for (int j = 0; j < 4; ++j) y[j] = v[i][j] * r * g4[j] * (1.f + sc[j]) + sh[j];
        store_bf16x4(h + (size_t)row * 1024 + col, y[0], y[1], y[2], y[3]);
    }
}
__device__ __forceinline__ void finalnorm_item(float* x, float* xo, const float* __restrict__ g, int item) {
    const int lane = VTID & 63, w = VTID >> 6;
    float* xr = x + (size_t)(item * 4 + w) * 1024;
    f32x4 v[4];
    float ss = 0.f;
#pragma unroll
    for (int i = 0; i < 4; ++i) {
        v[i] = *(const f32x4*)(xr + i * 256 + lane * 4);
        ss += v[i][0] * v[i][0] + v[i][1] * v[i][1] + v[i][2] * v[i][2] + v[i][3] * v[i][3];
    }
#pragma unroll
    for (int o = 32; o >= 1; o >>= 1) ss += __shfl_xor(ss, o);
    const float r = rsqrtf(ss * (1.f / 1024.f) + EPSF);
#pragma unroll
    for (int i = 0; i < 4; ++i) {
        const f32x4 g4 = *(const f32x4*)(g + i * 256 + lane * 4);
        store_f32x4_nt(xo + (size_t)(item * 4 + w) * 1024 + i * 256 + lane * 4, v[i] * r * g4);
    }
}

__device__ __forceinline__ int odmap(int n) {
    if (n < 416) return n;
    if (n < 512) return -1;
    const int t = n - 512, wt = t >> 6, c = t & 63;
    return 416 + (c < 32 ? wt * 32 + c : 512 + wt * 32 + (c - 32));
}
__device__ __forceinline__ int perm256(int n) { const int p = n & 255; return (n & ~255) + 64 * ((p >> 5) & 3) + 32 * (p >> 7) + (p & 31); }
template <bool ODMAP, bool P256, bool TILED = false>
__device__ __forceinline__ void tconv_tile(const float* __restrict__ src, int ldsrc, bf16_t* __restrict__ dst, int K, const float* __restrict__ rs,
                                           int tile, char* smem, int nrows_t = 0) {
    float* t = (float*)smem;
    const int nkt = K >> 6;
    const int kt = tile % nkt, ntile = tile / nkt;
    const int k0 = kt * 64, n0 = ntile * 64;
    const int tid = VTID;
    __syncthreads();
    {
        const int c4 = (tid & 15) * 4, kr = tid >> 4;
        const int ln = P256 ? perm256(n0 + c4) : n0 + c4;
        const int sn = ODMAP ? odmap(ln) : ln;
#pragma unroll
        for (int i = 0; i < 4; ++i) {
            const int k = i * 16 + kr;
            f32x4 v = sn >= 0 ? *(const f32x4*)(src + (size_t)(k0 + k) * ldsrc + sn) : (f32x4){0.f, 0.f, 0.f, 0.f};
            if (rs) v *= rs[k0 + k];
            t[k * 65 + c4 + 0] = v[0]; t[k * 65 + c4 + 1] = v[1]; t[k * 65 + c4 + 2] = v[2]; t[k * 65 + c4 + 3] = v[3];
        }
    }
    __syncthreads();
#pragma unroll
    for (int j = 0; j < 2; ++j) {
        const int n = (tid >> 3) + 32 * j, kc = (tid & 7) * 8;
        u32x4 o;
        o.x = pack_bf16(t[(kc + 0) * 65 + n], t[(kc + 1) * 65 + n]);
        o.y = pack_bf16(t[(kc + 2) * 65 + n], t[(kc + 3) * 65 + n]);
        o.z = pack_bf16(t[(kc + 4) * 65 + n], t[(kc + 5) * 65 + n]);
        o.w = pack_bf16(t[(kc + 6) * 65 + n], t[(kc + 7) * 65 + n]);
        if (TILED) *(u32x4*)(dst + ((size_t)kt * nrows_t + n0 + n) * 64 + kc) = o;
        else *(u32x4*)(dst + (size_t)(n0 + n) * K + k0 + kc) = o;
    }
}
__device__ __forceinline__ void upw_tile(const Params& p, bf16_t* __restrict__ dst, int tile, char* smem) {
    float* t = (float*)smem;
    const int kt = tile % 6, ntile = tile / 6;
    const int k0 = kt * 64, n0 = ntile * 64;
    const int tid = VTID;
    const bool isq = n0 < 768;
    const bool kvalid = isq ? (k0 < 256) : (k0 >= 256);
    const float* src = isq ? p.od_w_uq : p.od_w_ukv;
    const int ld = isq ? 768 : 1024;
    const int ks0 = isq ? k0 : k0 - 256;
    const float* rs = isq ? p.od_q_norm_g : p.od_kv_norm_g;
    __syncthreads();
    {
        const int n = tid & 63;
        const int ln = perm256(n0 + n) - (isq ? 0 : 768);
#pragma unroll
        for (int i = 0; i < 16; ++i) {
            const int k = i * 4 + (tid >> 6);
            t[k * 65 + n] = kvalid ? src[(size_t)(ks0 + k) * ld + ln] * rs[ks0 + k] : 0.f;
        }
    }
    __syncthreads();
#pragma unroll
    for (int j = 0; j < 2; ++j) {
        const int n = (tid >> 3) + 32 * j, kc = (tid & 7) * 8;
        u32x4 o;
        o.x = pack_bf16(t[(kc + 0) * 65 + n], t[(kc + 1) * 65 + n]);
        o.y = pack_bf16(t[(kc + 2) * 65 + n], t[(kc + 3) * 65 + n]);
        o.z = pack_bf16(t[(kc + 4) * 65 + n], t[(kc + 5) * 65 + n]);
        o.w = pack_bf16(t[(kc + 6) * 65 + n], t[(kc + 7) * 65 + n]);
        *(u32x4*)(dst + (size_t)(n0 + n) * 384 + k0 + kc) = o;
    }
}
__device__ __forceinline__ void ada_item(const Params& p, float* __restrict__ mod, int item, char* smem) {
    float* s = (float*)smem;
    const int tid = VTID;
    const int layer = item / 96, n0 = (item % 96) * 64;
    const int col = tid & 63, ks = tid >> 6;
    float acc[17];
#pragma unroll
    for (int r = 0; r < 17; ++r) acc[r] = 0.f;
    for (int half = 0; half < 2; ++half) {
        __syncthreads();
        for (int idx = tid; idx < 17 * 512; idx += 256) {
            const int r = idx >> 9, k = (idx & 511) + half * 512;
            const float v = r < 16 ? p.c[r * 1024 + k] : p.c_ctx[k];
            s[idx] = v * sigmoidf_(v);
        }
        __syncthreads();
        const float* wp = p.ada_w + ((size_t)layer * 1024 + half * 512 + ks * 128) * 6144 + n0 + col;
        for (int k0 = 0; k0 < 128; k0 += 16) {
            float wv[16];
#pragma unroll
            for (int kk = 0; kk < 16; ++kk) wv[kk] = wp[(size_t)(k0 + kk) * 6144];
#pragma unroll
            for (int kk = 0; kk < 16; ++kk)
#pragma unroll
                for (int r = 0; r < 17; ++r) acc[r] += s[r * 512 + ks * 128 + k0 + kk] * wv[kk];
        }
    }
    __syncthreads();
#pragma unroll
    for (int r = 0; r < 17; ++r) s[(ks * 17 + r) * 64 + col] = acc[r];
    __syncthreads();
    for (int idx = tid; idx < 17 * 64; idx += 256) {
        const int r = idx >> 6, cc = idx & 63;
        const float v = s[(0 * 17 + r) * 64 + cc] + s[(1 * 17 + r) * 64 + cc] + s[(2 * 17 + r) * 64 + cc] + s[(3 * 17 + r) * 64 + cc];
        mod[((size_t)layer * 17 + r) * 6144 + n0 + cc] = v + p.ada_b[layer * 6144 + n0 + cc];
    }
}

template <bool ODMAP>
__device__ __forceinline__ void bias_item(const float* __restrict__ vec, const float* __restrict__ W, int ldw, float* __restrict__ out, int ldo, int n0, char* smem) {
    float* s = (float*)smem;
    const int tid = VTID;
    const int col = tid & 63, ks = tid >> 6;
    const int sc = ODMAP ? odmap(n0 + col) : n0 + col;
    float acc[17];
#pragma unroll
    for (int r = 0; r < 17; ++r) acc[r] = 0.f;
    for (int half = 0; half < 2; ++half) {
        __syncthreads();
        for (int idx = tid; idx < 17 * 512; idx += 256) {
            const int r = idx >> 9, k = (idx & 511) + half * 512;
            s[idx] = vec[(size_t)r * 6144 + k];
        }
        __syncthreads();
        const float* wp = W + (size_t)(half * 512 + ks * 128) * ldw + (sc >= 0 ? sc : 0);
        for (int k0 = 0; k0 < 128; k0 += 16) {
            float wv[16];
#pragma unroll
            for (int kk = 0; kk < 16; ++kk) wv[kk] = sc >= 0 ? wp[(size_t)(k0 + kk) * ldw] : 0.f;
#pragma unroll
            for (int kk = 0; kk < 16; ++kk)
#pragma unroll
                for (int r = 0; r < 17; ++r) acc[r] += s[r * 512 + ks * 128 + k0 + kk] * wv[kk];
        }
    }
    __syncthreads();
#pragma unroll
    for (int r = 0; r < 17; ++r) s[(ks * 17 + r) * 64 + col] = acc[r];
    __syncthreads();
    for (int idx = tid; idx < 17 * 64; idx += 256) {
        const int r = idx >> 6, cc = idx & 63;
        out[(size_t)r * ldo + n0 + cc] = s[(0 * 17 + r) * 64 + cc] + s[(1 * 17 + r) * 64 + cc] + s[(2 * 17 + r) * 64 + cc] + s[(3 * 17 + r) * 64 + cc];
    }
}

constexpr int P0_EV = (1792 / 64) * 16;
constexpr int P0_OD = (1536 / 64) * 16;
constexpr int P0_WO = 2 * 16 * 16;
constexpr int P0_W1 = 2 * 64 * 16;
constexpr int P0_W2 = 2 * 16 * 64;
constexpr int P0_UQ = (1792 / 64) * 6;
constexpr int P0_UKV = 0;
constexpr int P0_SGU = 128;
constexpr int P0_ZERO = 180;
constexpr int P0_ADA = 192;
constexpr int P0_TOTAL = P0_ADA + P0_EV + P0_OD + P0_WO + P0_W1 + P0_W2 + P0_UQ + P0_UKV + P0_SGU + P0_ZERO;

__device__ __forceinline__ void phase0_item(const Params& p, int it, char* smem) {
    char* ws = p.ws;
    if (it < P0_ADA) { ada_item(p, (float*)(ws + OFF_MOD), it, smem); return; }
    it -= P0_ADA;
    if (it < P0_EV) { tconv_tile<false, true>(p.ev_w_in, 1792, (bf16_t*)(ws + OFF_EVWIN), 1024, nullptr, it, smem); return; }
    it -= P0_EV;
    if (it < P0_OD) { tconv_tile<true, true>(p.od_w_in, 1440, (bf16_t*)(ws + OFF_ODWIN), 1024, nullptr, it, smem); return; }
    it -= P0_OD;
    if (it < P0_WO) { const int l = it / 256; tconv_tile<false, true>(p.w_out + (size_t)l * 1024 * 1024, 1024, (bf16_t*)(ws + OFF_WOUT) + (size_t)l * 1024 * 1024, 1024, nullptr, it % 256, smem); return; }
    it -= P0_WO;
    if (it < P0_W1) { const int l = it / 1024; tconv_tile<false, true>(p.mlp_w1 + (size_t)l * 1024 * 4096, 4096, (bf16_t*)(ws + OFF_W1) + (size_t)l * 4096 * 1024, 1024, nullptr, it % 1024, smem); return; }
    it -= P0_W1;
    if (it < P0_W2) { const int l = it / 1024; tconv_tile<false, true, true>(p.mlp_w2 + (size_t)l * 4096 * 1024, 1024, (bf16_t*)(ws + OFF_W2) + (size_t)l * 1024 * 4096, 4096, nullptr, it % 1024, smem, 1024); return; }
    it -= P0_W2;
    if (it < P0_UQ) { upw_tile(p, (bf16_t*)(ws + OFF_WUP), it, smem); return; }
    it -= P0_UQ;
    if (it < P0_SGU) {
        const int e = it * 1024 + VTID * 4;
        const f32x4 v = *(const f32x4*)(p.ev_sgu_w + e);
        store_bf16x4((bf16_t*)(ws + OFF_SGUW) + e, v[0], v[1], v[2], v[3]);
        return;
    }
    it -= P0_SGU;
    { *(f32x4*)((float*)(ws + OFF_SSQ) + it * 1024 + VTID * 4) = (f32x4){0.f, 0.f, 0.f, 0.f}; }
}

namespace pg8 {
#define PG8_LAS __attribute__((address_space(3)))
typedef unsigned short bf16_t;
typedef short bf16x8 __attribute__((ext_vector_type(8)));
typedef float f32x4 __attribute__((ext_vector_type(4)));
typedef unsigned u32x4 __attribute__((ext_vector_type(4)));
constexpr int BM = 256, BK = 64, HALF = 128, HTB = HALF * BK * 2  , STAGE_BYTES = 8 * HTB, NXCD = 8, WGM = 8;

__host__ __device__ __forceinline__ int lds_byte(int r, int c) { const int st = (r >> 4) * 2 + (c >> 5), rr = r & 15, cc = c & 31, ob = rr * 64 + cc * 2; return st * 1024 + (ob ^ (((ob >> 9) & 1) << 5)); }
__host__ __device__ __forceinline__ void stage_rc(int b, int& R, int& C) { const int st = b / 1024, sb = b % 1024, swz = sb ^ (((sb >> 9) & 1) << 5); R = (st >> 1) * 16 + swz / 64; C = (st & 1) * 32 + (swz % 64) / 2; }
__host__ __device__ __forceinline__ int perm32(int rho) { const int n = rho >> 4, i = rho & 15; return 8 * (i >> 2) + 4 * n + (i & 3); }

struct Unit { int pm, pn, ks; };
struct Gemm { const bf16_t* A; const bf16_t* Bt; int M, N, K; int a_tiled, b_tiled, a_rows; };

struct StaticOrder {
    int nM, nN, nwg, G, c;
    __host__ __device__ void init(int M, int N, int G_, int c_) { nM = M / BM; nN = N / BM; nwg = nM * nN; G = G_; c = c_; }
    __host__ __device__ bool next(int i, Unit& u) const {
        const long L = (long)i * G + c; if (L >= nwg) return false;
        int wgid = (int)L; { const int q = nwg / NXCD, r = nwg % NXCD, xcd = wgid % NXCD, off = wgid / NXCD; wgid = (xcd < r ? xcd * (q + 1) : r * (q + 1) + (xcd - r) * q) + off; }
        const int nig = WGM * nN, gid = wgid / nig, fm = gid * WGM, gsz = (nM - fm) < WGM ? (nM - fm) : WGM;
        u.pm = fm + ((wgid % nig) % gsz); u.pn = (wgid % nig) / gsz; u.ks = 0; return true;
    }
    __device__ __forceinline__ void a_ready(const Unit&) const {}
    __device__ __forceinline__ void done(const Unit&) const {}
};
template <class Epi, class Sched, bool STAMP = false>
__device__ __forceinline__ void gemm_phase(PG8_LAS unsigned char* lds, const Gemm g, const Sched& S, const Epi& E, unsigned long long* stamps) {
    const int tid = (int)fresh_tid(), wid = __builtin_amdgcn_readfirstlane(tid >> 6), lane = tid & 63, wr = wid >> 2, wc = wid & 3, fr = lane & 15, fq = lane >> 4;
    const int K = g.K, nt = K / BK;
    int ts_lo = 0, ts_hi = 0, nts = 0; const unsigned long long rt_entry = STAMP ? (unsigned long long)wall_clock64() : 0ull;
#define PG8_STAMP() do { if (STAMP && wid == 0 && nts < 64) { const unsigned long long _c = (unsigned long long)clock64(); \
        ts_lo = (lane == nts) ? (int)(unsigned)_c : ts_lo; ts_hi = (lane == nts) ? (int)(unsigned)(_c >> 32) : ts_hi; ++nts; } } while (0)
    PG8_STAMP();
    unsigned voffA[2], voffB[2];
#pragma unroll
    for (int i = 0; i < 2; ++i) { int R, C; stage_rc(tid * 16 + i * 8192, R, C); const int Rb = Epi::PERM ? ((R & ~31) + perm32(R & 31)) : R;
        voffA[i] = (unsigned)(R * (g.a_tiled ? 64 : K) + C) * 2u; voffB[i] = (unsigned)(Rb * (g.b_tiled ? 64 : K) + C) * 2u; }
    const size_t kstepA = g.a_tiled ? (size_t)g.a_rows * (BK * 2) : (size_t)(BK * 2), kstepB = g.b_tiled ? (size_t)g.N * (BK * 2) : (size_t)(BK * 2);
    const size_t hstepA = (size_t)HALF * (g.a_tiled ? BK : K) * 2, hstepB = (size_t)HALF * (g.b_tiled ? BK : K) * 2;
    const size_t tstepA = 2 * hstepA, tstepB = 2 * hstepB;
    const size_t ksplitA = (size_t)nt * kstepA, ksplitB = (size_t)nt * kstepB;
    const unsigned ldsw = (unsigned)wid * 1024u;
    const int aoff = lds_byte(wr * 64 + fr, fq * 8), boff = lds_byte(wc * 32 + fr, fq * 8);
#define PG8_SA(b, h) (((b) * 2 + (h)) * HTB)
#define PG8_SB(b, h) ((4 + (b) * 2 + (h)) * HTB)
#define PG8_STAGE(bufoff, gbase, voff) do { _Pragma("unroll") for (int _i = 0; _i < 2; ++_i) \
        __builtin_amdgcn_global_load_lds((const unsigned*)((const char*)(gbase) + (voff)[_i]), (PG8_LAS unsigned*)(lds + (bufoff) + ldsw + _i * 8192), 16, 0, 0); } while (0)
#define PG8_LDA(dst, b, h) do { _Pragma("unroll") for (int m = 0; m < 4; ++m) _Pragma("unroll") for (int k = 0; k < 2; ++k) dst[m][k] = *(const PG8_LAS bf16x8*)(lds + PG8_SA(b, h) + aoff + m * 2048 + k * 1024); } while (0)
#define PG8_LDB(dst, b, h) do { _Pragma("unroll") for (int n = 0; n < 2; ++n) _Pragma("unroll") for (int k = 0; k < 2; ++k) dst[n][k] = *(const PG8_LAS bf16x8*)(lds + PG8_SB(b, h) + boff + n * 2048 + k * 1024); } while (0)
#define PG8_MMA(ai, bj, At, Bt) do { __builtin_amdgcn_s_setprio(1); _Pragma("unroll") for (int m = 0; m < 4; ++m) _Pragma("unroll") for (int n = 0; n < 2; ++n) _Pragma("unroll") for (int k = 0; k < 2; ++k) \
        acc[ai][bj][m][n] = __builtin_amdgcn_mfma_f32_16x16x32_bf16(Bt[n][k], At[m][k], acc[ai][bj][m][n], 0, 0, 0); __builtin_amdgcn_s_setprio(0); } while (0)
#define PG8_WAIT_V(n) asm volatile("s_waitcnt vmcnt(" #n ")" ::: "memory")
#define PG8_WAIT_L(n) asm volatile("s_waitcnt lgkmcnt(" #n ")" ::: "memory")
#define PG8_BAR __builtin_amdgcn_s_barrier()
#define PG8_SCHED __builtin_amdgcn_sched_barrier(0)
    Unit cur, nxt; int ui = 0;
    if (!S.next(0, cur)) return;
    f32x4 acc[2][2][4][2];
#pragma unroll
    for (int a = 0; a < 2; ++a)
#pragma unroll
        for (int b = 0; b < 2; ++b)
#pragma unroll
            for (int m = 0; m < 4; ++m)
#pragma unroll
                for (int n = 0; n < 2; ++n) acc[a][b][m][n] = (f32x4){0.f, 0.f, 0.f, 0.f};
    bf16x8 At[4][2], B0[2][2], B1[2][2];
    const char* cA = (const char*)g.A + (size_t)cur.pm * tstepA + (size_t)cur.ks * ksplitA; const char* cB = (const char*)g.Bt + (size_t)cur.pn * tstepB + (size_t)cur.ks * ksplitB;
    S.a_ready(cur);
    PG8_STAGE(PG8_SB(0, 0), cB, voffB); PG8_STAGE(PG8_SA(0, 0), cA, voffA); PG8_STAGE(PG8_SB(0, 1), cB + hstepB, voffB); PG8_STAGE(PG8_SA(0, 1), cA + hstepA, voffA);
    if (wr == 1) PG8_BAR;
    PG8_WAIT_V(4); PG8_BAR;
    PG8_STAGE(PG8_SB(1, 0), cB + kstepB, voffB); PG8_STAGE(PG8_SA(1, 0), cA + kstepA, voffA); PG8_STAGE(PG8_SB(1, 1), cB + hstepB + kstepB, voffB);
    PG8_WAIT_V(6); PG8_BAR;
    PG8_STAMP();
    for (;;) {
        const bool has_next = S.next(ui + 1, nxt);
        const char* nA = has_next ? (const char*)g.A + (size_t)nxt.pm * tstepA + (size_t)nxt.ks * ksplitA : cA; const char* nB = has_next ? (const char*)g.Bt + (size_t)nxt.pn * tstepB + (size_t)nxt.ks * ksplitB : cB;
        for (int t = 0; t < nt; t += 2) {
            const bool last = (t == nt - 2);
            const char* a1 = cA + (size_t)(t + 1) * kstepA;
            const char* a2 = last ? nA : cA + (size_t)(t + 2) * kstepA; const char* b2 = last ? nB : cB + (size_t)(t + 2) * kstepB;
            const char* a3 = a2 + kstepA; const char* b3 = b2 + kstepB;
            if (last && has_next) S.a_ready(nxt);
            PG8_LDB(B0, 0, 0); PG8_SCHED; PG8_LDA(At, 0, 0); PG8_STAGE(PG8_SA(1, 1), a1 + hstepA, voffA);
            PG8_WAIT_L(8); PG8_BAR; PG8_WAIT_L(0); PG8_MMA(0, 0, At, B0); PG8_BAR; PG8_SCHED;
            PG8_LDB(B1, 0, 1); PG8_STAGE(PG8_SB(0, 0), b2, voffB);
            PG8_BAR; PG8_WAIT_L(0); PG8_MMA(0, 1, At, B1); PG8_BAR;
            PG8_LDA(At, 0, 1); PG8_STAGE(PG8_SA(0, 0), a2, voffA);
            PG8_BAR; PG8_WAIT_L(0); PG8_MMA(1, 0, At, B0); PG8_BAR; PG8_SCHED;
            PG8_STAGE(PG8_SB(0, 1), b2 + hstepB, voffB);
            PG8_WAIT_V(6); PG8_BAR; PG8_MMA(1, 1, At, B1); PG8_BAR;
            PG8_LDB(B0, 1, 0); PG8_SCHED; PG8_LDA(At, 1, 0); PG8_STAGE(PG8_SA(0, 1), a2 + hstepA, voffA);
            PG8_WAIT_L(8); PG8_BAR; PG8_WAIT_L(0); PG8_MMA(0, 0, At, B0); PG8_BAR; PG8_SCHED;
            PG8_LDB(B1, 1, 1); PG8_STAGE(PG8_SB(1, 0), b3, voffB);
            PG8_BAR; PG8_WAIT_L(0); PG8_MMA(0, 1, At, B1); PG8_BAR;
            PG8_LDA(At, 1, 1); PG8_STAGE(PG8_SA(1, 0), a3, voffA);
            PG8_BAR; PG8_WAIT_L(0); PG8_MMA(1, 0, At, B0); PG8_BAR; PG8_SCHED;
            PG8_STAGE(PG8_SB(1, 1), b3 + hstepB, voffB);
            PG8_WAIT_V(6); PG8_BAR; PG8_MMA(1, 1, At, B1); PG8_BAR;
        }
        PG8_STAMP();
        if constexpr (!Epi::AFTER_DRAIN) { E(acc, cur, wr, wc, fr, fq); S.done(cur); }
        PG8_STAMP();
        if (!has_next) break;
#pragma unroll
        for (int a = 0; a < 2; ++a)
#pragma unroll
            for (int b = 0; b < 2; ++b)
#pragma unroll
                for (int m = 0; m < 4; ++m)
#pragma unroll
                    for (int n = 0; n < 2; ++n) acc[a][b][m][n] = (f32x4){0.f, 0.f, 0.f, 0.f};
        cur = nxt; cA = nA; cB = nB; ++ui;
    }
    PG8_WAIT_V(0);
    if (wr == 0) PG8_BAR;
    PG8_BAR;
    if constexpr (Epi::AFTER_DRAIN) { E.fused(acc, cur, wr, wc, fr, fq, lds, wid, lane); S.done(cur); }
    PG8_STAMP();
    if (STAMP && wid == 0) { stamps[lane] = lane < nts ? (((unsigned long long)(unsigned)ts_hi << 32) | (unsigned)ts_lo) : 0ull;
        if (lane == 62) stamps[62] = rt_entry; if (lane == 63) stamps[63] = (unsigned long long)wall_clock64(); }
#undef PG8_STAMP
#undef PG8_SA
#undef PG8_SB
#undef PG8_STAGE
#undef PG8_LDA
#undef PG8_LDB
#undef PG8_MMA
#undef PG8_WAIT_V
#undef PG8_WAIT_L
#undef PG8_BAR
#undef PG8_SCHED
}
}
template <class E, class = void> struct has_staged { static constexpr bool value = false; };
template <class E> struct has_staged<E, decltype((void)E::STAGED)> { static constexpr bool value = true; };
template <class E> struct EpiAdapt {
    static constexpr bool PERM = false, AFTER_DRAIN = false;
    E e; char* stage_base;
    __device__ __forceinline__ void operator()(const f32x4 (&acc)[2][2][4][2], const pg8::Unit& u, int wr, int wc, int fr, int fq) const {
        { const int lane_ = (int)(fresh_tid() & 63u); fr = lane_ & 15; fq = lane_ >> 4; }
        const int m0 = u.pm * 256 + wr * 64, n0 = u.pn * 256 + wc * 64;
        if constexpr (has_staged<E>::value) {
            const int lane = fq * 16 + fr;
            char* stg = stage_base + (wr * 4 + wc) * 4096;
            const typename E::SState st = e.sbegin(m0, n0, lane, u.ks);
            typename E::SLoad q[3];
            q[0] = e.sload(m0, n0, lane);
            q[1] = e.sload(m0 + 16, n0, lane);
#pragma unroll
            for (int gi = 0; gi < 8; ++gi) {
                const int ai = gi >> 2, m = gi & 3;
                if (gi < 6) q[(gi + 2) % 3] = e.sload(m0 + ((gi + 2) >> 2) * 128 + ((gi + 2) & 3) * 16, n0, lane);
                f32x4 a[4] = {acc[ai][0][m][0], acc[ai][0][m][1], acc[ai][1][m][0], acc[ai][1][m][1]};
                e.srow(a, st, q[gi % 3], gi, m0 + ai * 128 + m * 16, n0, lane, stg);
            }
        } else {
            const typename E::State st = e.begin(m0, n0, fr, fq);
#pragma unroll
            for (int ai = 0; ai < 2; ++ai)
#pragma unroll
                for (int m = 0; m < 4; ++m) {
                    f32x4 a[4] = {acc[ai][0][m][0], acc[ai][0][m][1], acc[ai][1][m][0], acc[ai][1][m][1]};
                    e.row(a, st, ai * 4 + m, m0 + ai * 128 + m * 16, n0, fr, fq);
                }
        }
    }
};
struct SplitOrder4 {
    int nM, nN, nwg, G, c;
    __device__ void init(int M, int N, int G_, int c_) { nM = M / 256; nN = N / 256; nwg = nM * nN * 4; G = G_; c = c_; }
    __device__ bool next(int i, pg8::Unit& u) const {
        const int L = i * G + c; if (L >= nwg) return false;
        u.ks = L & 3; const int t = L >> 2; u.pm = t / nN; u.pn = t % nN; return true;
    }
    __device__ __forceinline__ void a_ready(const pg8::Unit&) const {}
    __device__ __forceinline__ void done(const pg8::Unit&) const {}
};
template <class E>
__device__ __forceinline__ void big_gemm_split4(const bf16_t* A, const bf16_t* Bt, int M, int N, int Kq, int a_rows, const E& e, char* smem) {
    SplitOrder4 S; S.init(M, N, (int)gridDim.x, (int)blockIdx.x);
    EpiAdapt<E> ea{e, smem + 131072};
    pg8::gemm_phase<EpiAdapt<E>, SplitOrder4, false>((PG8_LAS unsigned char*)smem, pg8::Gemm{A, Bt, M, N, Kq, 1, 1, a_rows}, S, ea, nullptr);
}
template <class E>
__device__ __forceinline__ void big_gemm(const bf16_t* A, const bf16_t* Bt, int M, int N, int K, const E& e, char* smem, int a_tiled = 0, int b_tiled = 0, int a_rows = 0) {
    pg8::StaticOrder S; S.init(M, N, (int)gridDim.x, (int)blockIdx.x);
    EpiAdapt<E> ea{e, smem + 131072};
    pg8::gemm_phase<EpiAdapt<E>, pg8::StaticOrder, false>((PG8_LAS unsigned char*)smem, pg8::Gemm{A, Bt, M, N, K, a_tiled, b_tiled, a_rows ? a_rows : M}, S, ea, nullptr);
}

#define XB_TMO      128
#define XB_XCNT(j)  (256  + 64 * (j))
#define XB_XSUB(j)  (1280 + 64 * (j))
#define XB_XGEN(j)  (2304 + 64 * (j))
#define XB_TOP      3328
#define XB_TOPGEN   3392
#define XCD_BAR_WORDS 3456
#define XB_SPIN_CAP (1u << 20)
#define LAS __attribute__((address_space(3)))
__device__ __forceinline__ unsigned xb_ld(unsigned* p)              { return __hip_atomic_load(p, __ATOMIC_RELAXED, __HIP_MEMORY_SCOPE_AGENT); }
__device__ __forceinline__ unsigned xb_add(unsigned* p, unsigned v) { return __hip_atomic_fetch_add(p, v, __ATOMIC_RELAXED, __HIP_MEMORY_SCOPE_AGENT); }
__device__ __forceinline__ unsigned xb_xcc_id() { return (unsigned)__builtin_amdgcn_s_getreg((3 << 11) | 20) & 0xFu; }
#define XB_SPIN(cond, bar) do { unsigned _sp = 0; while (cond) { __builtin_amdgcn_s_sleep(1); \
    if ((++_sp & 255u) == 0u) { if (xb_ld(&(bar)[XB_TMO])) break; if (_sp > XB_SPIN_CAP) { atomicAdd(&(bar)[XB_TMO], 1u); break; } } } } while (0)
#define XB_SLOTS 4096
#define XB_TOTAL_WORDS (4096 + 2048)
struct XcdBarrier { unsigned* bar; unsigned x; unsigned* st; };
__device__ __forceinline__ XcdBarrier xcd_barrier_post(unsigned* bar) {
    XcdBarrier b; b.bar = bar; b.x = xb_xcc_id(); b.st = bar + XB_SLOTS + 2 * blockIdx.x;
    if (threadIdx.x == 0) (void)xb_add(&bar[XB_XCNT(b.x)], 1u);
    return b;
}
__device__ __forceinline__ void xcd_barrier_complete(unsigned* bar, unsigned x, unsigned& nloc, unsigned& nx) {
    const unsigned G = gridDim.x * gridDim.y * gridDim.z;
    unsigned sum, cnt, mine, sp = 0u;
    for (;;) {
        sum = 0u; cnt = 0u; mine = 0u;
#pragma unroll
        for (unsigned j = 0; j < 16; ++j) { const unsigned c = xb_ld(&bar[XB_XCNT(j)]); sum += c; cnt += (c > 0u) ? 1u : 0u; mine = (j == x) ? c : mine; }
        if (sum == G) break;
        __builtin_amdgcn_s_sleep(1);
        if ((++sp & 255u) == 0u) { if (xb_ld(&bar[XB_TMO])) break; if (sp > XB_SPIN_CAP) { atomicAdd(&bar[XB_TMO], 1u); break; } }
    }
    nloc = mine > 0u ? mine : 1u; nx = cnt > 0u ? cnt : 1u;
}
__device__ __forceinline__ void xcd_barrier(const XcdBarrier& b) {
    asm volatile("s_waitcnt vmcnt(0)" ::: "memory");
    __syncthreads();
    if (threadIdx.x == 0) {
        unsigned* bar = b.bar;
        __builtin_amdgcn_s_waitcnt(0);
        unsigned nloc = b.st[0], nx = b.st[1];
        if (nloc == 0u) { xcd_barrier_complete(bar, b.x, nloc, nx); b.st[0] = nloc; b.st[1] = nx; }
        const unsigned old = xb_add(&bar[XB_XSUB(b.x)], 1u);
        const unsigned gen = old / nloc;
        if (old + 1u == (gen + 1u) * nloc) {
            __builtin_amdgcn_fence(__ATOMIC_RELEASE, "agent");
            asm volatile("s_waitcnt vmcnt(0)" ::: "memory");
            const unsigned og = xb_add(&bar[XB_TOP], 1u);
            const unsigned tg = og / nx;
            if (og + 1u == (tg + 1u) * nx) xb_add(&bar[XB_TOPGEN], 1u);
            else XB_SPIN(xb_ld(&bar[XB_TOPGEN]) == tg, bar);
            __builtin_amdgcn_fence(__ATOMIC_ACQUIRE, "agent");
            xb_add(&bar[XB_XGEN(b.x)], 1u);
            asm volatile("s_waitcnt vmcnt(0)" ::: "memory");
        } else {
            XB_SPIN(xb_ld(&bar[XB_XGEN(b.x)]) == gen, bar);
            __builtin_amdgcn_fence(__ATOMIC_ACQUIRE, "agent");
            asm volatile("s_waitcnt vmcnt(0)" ::: "memory");
        }
    }
    __syncthreads();
}

#define NPHASES 17
#define SMEM_BYTES 34816

template <bool DUP = false>
__device__ __forceinline__ void run_phase(const Params& p, int ph, char* smem0) {
    char* ws = p.ws;
    const int half_ = (int)(fresh_tid() >> 8);
    const int G = 2 * gridDim.x, B = 2 * blockIdx.x + half_;
    char* smem = smem0 + half_ * 65536;
    float* mod = (float*)(ws + OFF_MOD);
    float* xctx = (float*)(ws + OFF_XCTX);
    bf16_t* h = (bf16_t*)(ws + OFF_H);
    bf16_t* hid = (bf16_t*)(ws + OFF_HID);
    bf16_t* omix = (bf16_t*)(ws + OFF_OMIX);
    float* ssq_q = (float*)(ws + OFF_SSQ);
    float* ssq_kv = ssq_q + NTOK;
    float* ssq_a = ssq_q + 2 * NTOK;
    float* ssq_b = ssq_q + 3 * NTOK;
    float* ssq_c = ssq_q + 4 * NTOK;
    float* bias0 = (float*)(ws + OFF_BIAS);
    float* bias1 = bias0 + 17 * 4096;
    float* bias2 = bias1 + 17 * 1536;
    switch (ph) {
    case 0:
        for (int it = B; it < P0_TOTAL; it += G) phase0_item(p, it, smem);
        break;
    case 1:
        for (int it = B; it < 152 + NTOK / 4; it += G) {
            if (it < 64) bias_item<false>(mod + 3 * 1024, p.mlp_w1, 4096, bias0, 4096, it * 64, smem);
            else if (it < 88) bias_item<true>(mod + 17 * 6144, p.od_w_in, 1440, bias1, 1536, (it - 64) * 64, smem);
            else if (it < 152) bias_item<false>(mod + 17 * 6144 + 3 * 1024, p.mlp_w1 + (size_t)1024 * 4096, 4096, bias2, 4096, (it - 88) * 64, smem);
            else modulate_item(p.x, p.ctx, p.norm1_g, mod, 0, 1024, h, it - 152);
        }
        break;
    case 2: {
        EpiEvenIn e{(bf16_t*)(ws + OFF_Q), (bf16_t*)(ws + OFF_QC), (bf16_t*)(ws + OFF_K), (bf16_t*)(ws + OFF_VT), (bf16_t*)(ws + OFF_U),
                    (bf16_t*)(ws + OFF_VGT), p.ev_q_norm_g, p.ev_k_norm_g, p.ev_sgu_norm_g, smem0 + 131072};
        big_gemm(h, (const bf16_t*)(ws + OFF_EVWIN), NTOK, 1792, 1024, e, smem0);
    } break;
    case 3: {
        const int n1 = 16 * 8 * 8, n2 = 16 * 8 * 1, n3 = 8 * 144;
        const float cexp = 0.125f * 1.4426950408889634f;
        for (int it = blockIdx.x; it < n1 + n2; it += gridDim.x) {
            const bool lat = it < n1;
            attn_item<64>((const bf16_t*)(ws + (lat ? OFF_Q : OFF_QC)), (const bf16_t*)(ws + OFF_K), (const bf16_t*)(ws + OFF_VT), omix, lat ? it : it - n1,
                          lat ? 2048 : 256, lat ? LK : 256, 4, lat ? 0 : NLAT, cexp, smem0);
        }
        {
            const int h2 = (int)(fresh_tid() >> 8);
            char* sm2 = smem0 + h2 * 65536;
            for (int t = 2 * blockIdx.x + h2; t < n3; t += G) {
                const int g = t / 144, pn = t % 144;
                EpiGate e{(const bf16_t*)(ws + OFF_U), omix, p.ev_sgu_b + g * 128, g};
                gemm_tile((const bf16_t*)(ws + OFF_SGUW) + g * 16384, 128, (const bf16_t*)(ws + OFF_VGT) + (size_t)g * 288 * 64 * 128, 128, 128, 0, pn, e, sm2);
            }
        }
    } break;
    case 4: {
        EpiResid<true, DUP ? 1 : 0> e{p.x, p.ctx, p.out, xctx, mod + 2 * 1024, h, p.norm2_g, mod + 4 * 1024, ssq_a};
        big_gemm(omix, (const bf16_t*)(ws + OFF_WOUT), NTOK, 1024, 1024, e, smem0);
    } break;
    case 5:
        for (int it = B; it < NTOK / 4; it += G) modulate_item(p.out, xctx, p.norm2_g, mod, 3 * 1024, 4 * 1024, h, it);
        break;
    case 6: {
        EpiSqRelu e{hid, ssq_a, bias0, NTOK};
        big_gemm(h, (const bf16_t*)(ws + OFF_W1), NTOK, 4096, 1024, e, smem0);
    } break;
    case 7: {
        EpiResid<true, DUP ? 2 : 0> e{p.out, xctx, p.out, xctx, mod + 5 * 1024, h, p.norm1_g + 1024, mod + 17 * 6144 + 1024, ssq_b};
        big_gemm(hid, (const bf16_t*)(ws + OFF_W2), NLAT, 1024, 4096, e, smem0, 1, 1, NTOK);
        EpiPartial ep{(float*)(ws + OFF_PART), NCTX};
        big_gemm_split4(hid + (size_t)NLAT * 64, (const bf16_t*)(ws + OFF_W2), NCTX, 1024, 1024, NTOK, ep, smem0);
    } break;
    case 8:
        for (int it = B; it < NTOK / 4; it += G) modulate_item(p.out, xctx, p.norm1_g + 1024, mod + 17 * 6144, 0, 1024, h, it);
        break;
    case 9: {
        EpiOddIn<DUP ? 1 : 0> e{(bf16_t*)(ws + OFF_CQ), (bf16_t*)(ws + OFF_CKV), (bf16_t*)(ws + OFF_K2), (bf16_t*)(ws + OFF_GLU), ssq_q, ssq_b, bias1, smem0 + 131072};
        big_gemm(h, (const bf16_t*)(ws + OFF_ODWIN), NTOK, 1536, 1024, e, smem0);
    } break;
    case 10: {
        EpiUp e{(bf16_t*)(ws + OFF_Q2), (bf16_t*)(ws + OFF_K2), (bf16_t*)(ws + OFF_V2T), ssq_q, ssq_kv, smem0 + 131072};
        big_gemm((const bf16_t*)(ws + OFF_CQ), (const bf16_t*)(ws + OFF_WUP), NTOK, 1792, 384, e, smem0);
        {
            const int h2 = (int)(fresh_tid() >> 8);
            char* sm2 = smem0 + h2 * 65536;
            for (int it = 2 * blockIdx.x + h2; it < NLAT / 16; it += G) conv_item((const bf16_t*)(ws + OFF_GLU), p.od_conv_w, p.od_conv_b, p.od_ln_g, p.od_ln_b, omix, it, sm2);
        }
    } break;
    case 11: {
        const float cexp = 0.10206207261596575f * 1.4426950408889634f;
        for (int it = blockIdx.x; it < 16 * 8 * 8; it += gridDim.x)
            attn_item<96>((const bf16_t*)(ws + OFF_Q2), (const bf16_t*)(ws + OFF_K2), (const bf16_t*)(ws + OFF_V2T), omix, it, 2048, LK, 1, 0, cexp, smem0);
    } break;
    case 12: {
        EpiResid<true, DUP ? 2 : 0> e{p.out, xctx, p.out, xctx, mod + 17 * 6144 + 2 * 1024, h, p.norm2_g + 1024, mod + 17 * 6144 + 4 * 1024, ssq_c};
        big_gemm(omix, (const bf16_t*)(ws + OFF_WOUT) + 1024 * 1024, NLAT, 1024, 1024, e, smem0);
    } break;
    case 13:
        for (int it = B; it < NLAT / 4; it += G) modulate_item(p.out, xctx, p.norm2_g + 1024, mod + 17 * 6144, 3 * 1024, 4 * 1024, h, it);
        break;
    case 14: {
        EpiSqRelu e{hid, ssq_c, bias2, NLAT};
        big_gemm(h, (const bf16_t*)(ws + OFF_W1) + (size_t)4096 * 1024, NLAT, 4096, 1024, e, smem0);
    } break;
    case 15: {
        EpiResid<false, DUP ? 2 : 0> e{p.out, xctx, p.out, xctx, mod + 17 * 6144 + 5 * 1024, nullptr, nullptr, nullptr, nullptr};
        big_gemm(hid, (const bf16_t*)(ws + OFF_W2) + (size_t)1024 * 4096, NLAT, 1024, 4096, e, smem0, 1, 1);
    } break;
    case 17:
        for (int it = B; it < NCTX / 4; it += G)
            combine_item((const float*)(ws + OFF_PART), xctx, mod + 16 * 6144 + 5 * 1024, p.norm1_g + 1024, mod + 17 * 6144 + 16 * 6144 + 1024, h, ssq_b, it, DUP);
        break;
    case 16:
        for (int it = B; it < NLAT / 4; it += G) finalnorm_item(p.out, DUP ? (float*)(ws + OFF_BIG) : p.out, p.final_g, it);
        break;
    }
}

#define LDS_TOTAL (131072 + 32768)
#if MK_COOP
__global__ void __launch_bounds__(512, 2) mega_coop(Params p) {
    extern __shared__ __attribute__((aligned(16))) char smem[];
    cg::grid_group grid = cg::this_grid();
    XcdBarrier xb = xcd_barrier_post((unsigned*)(p.ws + OFF_BAR));
    if (p.ws == nullptr) grid.sync();
    run_phase(p, 0, smem);
    xcd_barrier(xb);
#ifndef DUP_A
#define DUP_A -1
#define DUP_B -1
#endif
#define PH(n) run_phase(p, n, smem); xcd_barrier(xb); if (n == DUP_A || n == DUP_B) { run_phase<true>(p, n, smem); xcd_barrier(xb); }
    PH(1) PH(2) PH(3) PH(4) PH(6) PH(7) PH(17) PH(9) PH(10) PH(11) PH(12) PH(14) PH(15)
#undef PH
    run_phase(p, 16, smem);
    if (DUP_A == 16) { xcd_barrier(xb); run_phase<true>(p, 16, smem); }
}
#else
__global__ void __launch_bounds__(512, 2) mega_phase(Params p, int ph) {
    extern __shared__ __attribute__((aligned(16))) char smem[];
#ifdef ONLY_PH
    run_phase(p, ONLY_PH, smem);
#else
    run_phase(p, ph, smem);
#endif
}
#endif

extern "C" void kernel_launch(void* const* d_in, const int* in_sizes, int n_in, void* d_out, int out_size, void* d_ws, size_t ws_size,
                              hipStream_t stream) {
    Params p{};
    const float** f = (const float**)&p;
    for (int i = 0; i < 27; ++i) f[i] = (const float*)d_in[i];
    p.out = (float*)d_out;
    p.ws = (char*)d_ws;
    static int grid_blocks = 0;
    if (!grid_blocks) {
        int dev = 0, cus = 0, per_cu = 0;
        (void)hipGetDevice(&dev);
        (void)hipDeviceGetAttribute(&cus, hipDeviceAttributeMultiprocessorCount, dev);
#if MK_COOP
        (void)hipFuncSetAttribute((const void*)mega_coop, hipFuncAttributeMaxDynamicSharedMemorySize, LDS_TOTAL);
        (void)hipOccupancyMaxActiveBlocksPerMultiprocessor(&per_cu, mega_coop, 512, LDS_TOTAL);
#else
        (void)hipFuncSetAttribute((const void*)mega_phase, hipFuncAttributeMaxDynamicSharedMemorySize, LDS_TOTAL);
        (void)hipOccupancyMaxActiveBlocksPerMultiprocessor(&per_cu, mega_phase, 512, LDS_TOTAL);
#endif
        if (per_cu < 1) per_cu = 1;
        if (per_cu > 1) per_cu = 1;
        grid_blocks = cus * per_cu;
    }
#if MK_COOP
    (void)hipMemsetAsync((char*)d_ws + OFF_BAR, 0, XB_TOTAL_WORDS * 4, stream);
    void* args[] = {&p};
    hipError_t e = hipLaunchCooperativeKernel((void*)mega_coop, dim3(grid_blocks), dim3(512), args, LDS_TOTAL, stream);
    if (e != hipSuccess) fprintf(stderr, "cooperative launch failed: %s (grid %d)\n", hipGetErrorString(e), grid_blocks);
#else
    for (int ph = 0; ph < NPHASES; ++ph) if (ph != 5 && ph != 8 && ph != 13) mega_phase<<<grid_blocks, 512, LDS_TOTAL, stream>>>(p, ph);
#endif
}
```
